# Optimizing an MI355X kernel written in HIP

```python
import jax, jax.numpy as jnp
from jax import lax
import numpy as np

D_MODEL = 1024
BATCH = 2
SEQ = 8192
DEPTH = 2

RMS_EPS = 1e-6
NEG_INF = -1e30
Q_BLOCK = 128

GLA_HEADS = 4
GLA_DK = 64
GLA_DV = 128
GLA_GATE_RANK = 16
GLA_TAU = 16.0
GLA_CHUNK = 64

DSA_HEADS = 4
DSA_HEAD_DIM = 64
IDX_HEADS = 8
IDX_DIM = 32
DSA_TOPK = 256

MLA_HEADS = 4
MLA_Q_RANK = 192
MLA_KV_RANK = 128
MLA_NOPE_DIM = 64
MLA_ROPE_DIM = 32
MLA_V_DIM = 64
MLA_QK_DIM = MLA_NOPE_DIM + MLA_ROPE_DIM
ROPE_THETA = 10000.0

D_FF = 4 * D_MODEL

GLA_WIDTH = GLA_HEADS * GLA_DV
DSA_WIDTH = DSA_HEADS * DSA_HEAD_DIM
MLA_WIDTH = MLA_HEADS * MLA_V_DIM
D_MIX = GLA_WIDTH + DSA_WIDTH + MLA_WIDTH

IN_SPLITS = (
    GLA_HEADS * GLA_DK,
    GLA_HEADS * GLA_DK,
    GLA_WIDTH,
    GLA_WIDTH,
    GLA_GATE_RANK,
    DSA_WIDTH,
    DSA_WIDTH,
    DSA_WIDTH,
    IDX_HEADS * IDX_DIM,
    IDX_DIM,
    IDX_HEADS,
    MLA_Q_RANK,
    MLA_KV_RANK,
    MLA_ROPE_DIM,
)
D_IN = sum(IN_SPLITS)

kernel_name = "hybrid_gla_dsa_mla_parallel_heads"


def rms_norm(x, gain):
    xf = x.astype(jnp.float32)
    y = xf * lax.rsqrt(jnp.mean(xf * xf, axis=-1, keepdims=True) + RMS_EPS)
    return (y * gain.astype(jnp.float32)).astype(x.dtype)


def rotary(x, pos):
    half = x.shape[-1] // 2
    inv_freq = ROPE_THETA ** (-jnp.arange(half, dtype=jnp.float32) / half)
    ang = pos.astype(jnp.float32)[:, None] * inv_freq[None, :]
    cos = jnp.cos(ang)[None, :, None, :]
    sin = jnp.sin(ang)[None, :, None, :]
    xf = x.astype(jnp.float32)
    x1, x2 = xf[..., :half], xf[..., half:]
    return jnp.concatenate([x1 * cos - x2 * sin, x2 * cos + x1 * sin], axis=-1).astype(x.dtype)


def split_columns(proj):
    outs, start = [], 0
    for width in IN_SPLITS:
        outs.append(proj[..., start:start + width])
        start += width
    return outs


def gla_chunked(q, k, v, log_a):
    B, S, H, DK = q.shape
    DV = v.shape[-1]
    C = GLA_CHUNK
    N = S // C

    def chunks(t):
        return t.astype(jnp.float32).reshape(B, N, C, H, t.shape[-1]).transpose(0, 1, 3, 2, 4)

    qc = chunks(q) * (DK ** -0.5)
    kc, vc, gc = chunks(k), chunks(v), chunks(log_a)
    b = jnp.cumsum(gc, axis=3)
    b_end = b[:, :, :, -1:, :]
    q_dec = qc * jnp.exp(b)
    k_inv = kc * jnp.exp(-b)
    causal = jnp.tril(jnp.ones((C, C), dtype=bool))
    scores = jnp.where(causal, jnp.einsum('bnhcd,bnhsd->bnhcs', q_dec, k_inv), 0.0)
    o_intra = jnp.einsum('bnhcs,bnhsv->bnhcv', scores, vc)
    k_end = kc * jnp.exp(b_end - b)
    state_inc = jnp.einsum('bnhcd,bnhcv->bnhdv', k_end, vc)
    chunk_decay = jnp.exp(b_end[:, :, :, 0, :])

    def step(state, inp):
        dec, inc = inp
        return dec[..., None] * state + inc, state

    init = jnp.zeros((B, H, DK, DV), jnp.float32)
    _, s_prev = lax.scan(step, init, (jnp.moveaxis(chunk_decay, 1, 0), jnp.moveaxis(state_inc, 1, 0)))
    s_prev = jnp.moveaxis(s_prev, 0, 1)
    o = o_intra + jnp.einsum('bnhcd,bnhdv->bnhcv', q_dec, s_prev)
    return o.transpose(0, 1, 3, 2, 4).reshape(B, S, H, DV)


def to_blocks(t, nb):
    return jnp.moveaxis(t.reshape((t.shape[0], nb, Q_BLOCK) + t.shape[2:]), 1, 0)


def dsa_attention(q, k, v, iq, ik, iw):
    B, S, H, Dh = q.shape
    L = k.shape[1]
    top_k = min(DSA_TOPK, L // 4)
    nb = S // Q_BLOCK
    key_pos = jnp.arange(L)
    starts = jnp.arange(nb) * Q_BLOCK
    gather = jax.vmap(lambda table, idx: table[idx])
    scale = Dh ** -0.5

    def one_block(args):
        qb, iqb, iwb, t0 = args
        q_pos = t0 + jnp.arange(Q_BLOCK)
        rel = jax.nn.relu(jnp.einsum('bqhd,bsd->bqhs', iqb, ik))
        score = jnp.einsum('bqhs,bqh->bqs', rel, iwb).astype(jnp.float32)
        visible = key_pos[None, :] <= q_pos[:, None]
        score = jnp.where(visible[None], score, NEG_INF)
        _, idx = lax.top_k(score, top_k)
        valid = idx <= q_pos[None, :, None]
        k_sel = gather(k, idx)
        v_sel = gather(v, idx)
        logits = jnp.einsum('bqhd,bqkhd->bqhk', qb, k_sel).astype(jnp.float32) * scale
        logits = jnp.where(valid[:, :, None, :], logits, NEG_INF)
        p = jax.nn.softmax(logits, axis=-1).astype(v.dtype)
        return jnp.einsum('bqhk,bqkhd->bqhd', p, v_sel)

    out = lax.map(one_block, (to_blocks(q, nb), to_blocks(iq, nb), to_blocks(iw, nb), starts))
    return jnp.moveaxis(out, 0, 1).reshape(B, S, H, Dh)


def causal_block_attention(q, k, v):
    B, S, H, Dq = q.shape
    Dv = v.shape[-1]
    L = k.shape[1]
    nb = S // Q_BLOCK
    key_pos = jnp.arange(L)
    starts = jnp.arange(nb) * Q_BLOCK
    scale = Dq ** -0.5

    def one_block(args):
        qb, t0 = args
        q_pos = t0 + jnp.arange(Q_BLOCK)
        logits = jnp.einsum('bqhd,bshd->bhqs', qb, k).astype(jnp.float32) * scale
        visible = key_pos[None, :] <= q_pos[:, None]
        logits = jnp.where(visible[None, None], logits, NEG_INF)
        p = jax.nn.softmax(logits, axis=-1).astype(v.dtype)
        return jnp.einsum('bhqs,bshd->bqhd', p, v)

    out = lax.map(one_block, (to_blocks(q, nb), starts))
    return jnp.moveaxis(out, 0, 1).reshape(B, S, H, Dv)


def token_mix(h, pos, w_in, gla_gate_up, gla_gate_bias, gla_out_norm,
              dsa_q_norm, dsa_k_norm, dsa_out_norm,
              mla_q_latent_norm, mla_kv_latent_norm, mla_w_uq, mla_w_ukv,
              mla_q_norm, mla_k_norm, mla_out_norm, w_out):
    B, S, _ = h.shape
    proj = h @ w_in
    (g_q, g_k, g_v, g_gate, g_lr, d_q, d_k, d_v,
     i_q, i_k, i_w, m_cq, m_ckv, m_kr) = split_columns(proj)

    def heads(t, n):
        return t.reshape(B, S, n, t.shape[-1] // n)

    log_a = jax.nn.log_sigmoid((g_lr @ gla_gate_up + gla_gate_bias).astype(jnp.float32)) / GLA_TAU
    o_gla = gla_chunked(heads(g_q, GLA_HEADS), heads(g_k, GLA_HEADS),
                        heads(g_v, GLA_HEADS), heads(log_a, GLA_HEADS)).astype(h.dtype)
    o_gla = rms_norm(o_gla, gla_out_norm).reshape(B, S, GLA_WIDTH) * jax.nn.silu(g_gate)

    q_d = rms_norm(heads(d_q, DSA_HEADS), dsa_q_norm)
    k_d = rms_norm(heads(d_k, DSA_HEADS), dsa_k_norm)
    v_d = heads(d_v, DSA_HEADS)
    idx_w = i_w * ((IDX_HEADS * IDX_DIM) ** -0.5)
    o_dsa = dsa_attention(q_d, k_d, v_d, heads(i_q, IDX_HEADS), i_k, idx_w)
    o_dsa = rms_norm(o_dsa, dsa_out_norm).reshape(B, S, DSA_WIDTH)

    q_m = heads(rms_norm(m_cq, mla_q_latent_norm) @ mla_w_uq, MLA_HEADS)
    kv_m = heads(rms_norm(m_ckv, mla_kv_latent_norm) @ mla_w_ukv, MLA_HEADS)
    k_nope, v_m = kv_m[..., :MLA_NOPE_DIM], kv_m[..., MLA_NOPE_DIM:]
    k_rope = jnp.broadcast_to(m_kr[:, :, None, :], (B, S, MLA_HEADS, MLA_ROPE_DIM))
    q_m = rms_norm(q_m, mla_q_norm)
    k_m = rms_norm(jnp.concatenate([k_nope, k_rope], axis=-1), mla_k_norm)
    q_m = jnp.concatenate([q_m[..., :MLA_NOPE_DIM], rotary(q_m[..., MLA_NOPE_DIM:], pos)], axis=-1)
    k_m = jnp.concatenate([k_m[..., :MLA_NOPE_DIM], rotary(k_m[..., MLA_NOPE_DIM:], pos)], axis=-1)
    o_mla = causal_block_attention(q_m, k_m, v_m)
    o_mla = rms_norm(o_mla, mla_out_norm).reshape(B, S, MLA_WIDTH)

    return jnp.concatenate([o_gla, o_dsa, o_mla], axis=-1) @ w_out


def squared_relu_mlp(h, w_up, w_down):
    return jnp.square(jax.nn.relu(h @ w_up)) @ w_down


def setup_inputs(seed: int = 0) -> dict:
    key = jax.random.key(seed)
    ks = jax.random.split(key, 24)
    f32 = jnp.float32

    def dense(k, shape, fan_in, scale=1.0):
        return jax.random.normal(k, shape, f32) * (scale * fan_in ** -0.5)

    def gain(k, shape):
        return 1.0 + 0.02 * jax.random.normal(k, shape, f32)

    res_scale = (2 * DEPTH) ** -0.5
    return {
        "x": jax.random.normal(ks[0], (BATCH, SEQ, D_MODEL), f32),
        "attn_norm": gain(ks[1], (DEPTH, D_MODEL)),
        "w_in": dense(ks[2], (DEPTH, D_MODEL, D_IN), D_MODEL),
        "gla_gate_up": dense(ks[3], (DEPTH, GLA_GATE_RANK, GLA_HEADS * GLA_DK), GLA_GATE_RANK),
        "gla_gate_bias": 0.1 * jax.random.normal(ks[4], (DEPTH, GLA_HEADS * GLA_DK), f32),
        "gla_out_norm": gain(ks[5], (DEPTH, GLA_HEADS, GLA_DV)),
        "dsa_q_norm": gain(ks[6], (DEPTH, DSA_HEAD_DIM)),
        "dsa_k_norm": gain(ks[7], (DEPTH, DSA_HEAD_DIM)),
        "dsa_out_norm": gain(ks[8], (DEPTH, DSA_HEADS, DSA_HEAD_DIM)),
        "mla_q_latent_norm": gain(ks[9], (DEPTH, MLA_Q_RANK)),
        "mla_kv_latent_norm": gain(ks[10], (DEPTH, MLA_KV_RANK)),
        "mla_w_uq": dense(ks[11], (DEPTH, MLA_Q_RANK, MLA_HEADS * MLA_QK_DIM), MLA_Q_RANK),
        "mla_w_ukv": dense(ks[12], (DEPTH, MLA_KV_RANK, MLA_HEADS * (MLA_NOPE_DIM + MLA_V_DIM)), MLA_KV_RANK),
        "mla_q_norm": gain(ks[13], (DEPTH, MLA_QK_DIM)),
        "mla_k_norm": gain(ks[14], (DEPTH, MLA_QK_DIM)),
        "mla_out_norm": gain(ks[15], (DEPTH, MLA_HEADS, MLA_V_DIM)),
        "w_out": dense(ks[16], (DEPTH, D_MIX, D_MODEL), D_MIX, res_scale),
        "mlp_norm": gain(ks[17], (DEPTH, D_MODEL)),
        "w_up": dense(ks[18], (DEPTH, D_MODEL, D_FF), D_MODEL),
        "w_down": dense(ks[19], (DEPTH, D_FF, D_MODEL), D_FF, res_scale),
    }


def reference(x, attn_norm, w_in, gla_gate_up, gla_gate_bias, gla_out_norm,
              dsa_q_norm, dsa_k_norm, dsa_out_norm,
              mla_q_latent_norm, mla_kv_latent_norm, mla_w_uq, mla_w_ukv,
              mla_q_norm, mla_k_norm, mla_out_norm, w_out,
              mlp_norm, w_up, w_down):
    pos = jnp.arange(x.shape[1], dtype=jnp.int32)
    for l in range(DEPTH):
        h = rms_norm(x, attn_norm[l])
        x = x + token_mix(h, pos, w_in[l], gla_gate_up[l], gla_gate_bias[l], gla_out_norm[l],
                          dsa_q_norm[l], dsa_k_norm[l], dsa_out_norm[l],
                          mla_q_latent_norm[l], mla_kv_latent_norm[l], mla_w_uq[l], mla_w_ukv[l],
                          mla_q_norm[l], mla_k_norm[l], mla_out_norm[l], w_out[l])
        h = rms_norm(x, mlp_norm[l])
        x = x + squared_relu_mlp(h, w_up[l], w_down[l])
    return x
```

```cpp
#include <hip/hip_runtime.h>
#include <hip/hip_cooperative_groups.h>
#include <cstdio>
#include <cstdint>
namespace cg = cooperative_groups;

#ifndef N_LAUNCH_MODE
#define N_LAUNCH_MODE 0
#endif

#define DI __device__ __forceinline__
typedef unsigned short bf16_t;
typedef short bf16x8 __attribute__((ext_vector_type(8)));
typedef short bf16x4 __attribute__((ext_vector_type(4)));
typedef float f32x4 __attribute__((ext_vector_type(4)));
typedef float f32x16 __attribute__((ext_vector_type(16)));
typedef unsigned u32x4 __attribute__((ext_vector_type(4)));
typedef unsigned u32x2 __attribute__((ext_vector_type(2)));

constexpr int SEQ = 8192, MTOK = 16384, DM = 1024, NP = 3072, DIN = 2968, DFF = 4096;
constexpr int C_GQ = 0, C_GK = 256, C_GV = 512, C_GG = 1024, C_GLR = 1536, C_DQ = 1552, C_DK = 1808, C_DV = 2064,
              C_IQ = 2320, C_IK = 2576, C_IW = 2608, C_MCQ = 2616, C_MCKV = 2808, C_MKR = 2936;
constexpr float RMS_EPS = 1e-6f;
constexpr float LOG2E = 1.4426950408889634f;
constexpr float DSA_QS = 0.125f * LOG2E;
constexpr float MLA_QS = 0.10206207261596577f * LOG2E;
constexpr int NPH = 12;
constexpr int LDS_BYTES = 147456;
constexpr int CAND_CAP = 768;

constexpr size_t MiB = 1u << 20;
constexpr size_t WS_WIN = 1 * MiB, WS_WOUT = 7 * MiB, WS_WUP = 9 * MiB, WS_WDOWN = 17 * MiB, WS_WUQ = 25 * MiB, WS_WUKV = 25 * MiB + 256 * 1024;
constexpr size_t WS_ROPE = 26 * MiB;
constexpr size_t WS_XN = 27 * MiB;
constexpr size_t WS_PROJ = 59 * MiB;
constexpr size_t WS_GLA = 155 * MiB;
constexpr size_t WS_U = 59 * MiB;
constexpr size_t WS_GDEC = 187 * MiB;
constexpr size_t WS_MASK = 188 * MiB;
constexpr size_t WS_VDT = 204 * MiB;
constexpr size_t WS_QM = 212 * MiB;
constexpr size_t WS_KM = 224 * MiB;
constexpr size_t WS_VMT = 236 * MiB;
constexpr size_t WS_END = 244 * MiB;

struct Args { const float* in[20]; float* out; unsigned char* ws; int ph_lo, ph_hi; };

DI float bf2f(bf16_t v) { return __uint_as_float((unsigned)v << 16); }
DI bf16_t f2bf(float f) { unsigned u = __float_as_uint(f); return (bf16_t)((u + 0x7fffu + ((u >> 16) & 1u)) >> 16); }
DI unsigned pk2(float lo, float hi) { return (unsigned)f2bf(lo) | ((unsigned)f2bf(hi) << 16); }
DI f32x4 mfma16(bf16x8 a, bf16x8 b, f32x4 c) { return __builtin_amdgcn_mfma_f32_16x16x32_bf16(a, b, c, 0, 0, 0); }
DI f32x16 mfma32(bf16x8 a, bf16x8 b, f32x16 c) { return __builtin_amdgcn_mfma_f32_32x32x16_bf16(a, b, c, 0, 0, 0); }
DI float wave_sum(float v) {
#pragma unroll
    for (int o = 1; o < 64; o <<= 1) v += __shfl_xor(v, o);
    return v;
}
DI int crow(int r, int hi) { return (r & 3) + 8 * (r >> 2) + 4 * hi; }
#define LDS_FENCE() asm volatile("s_waitcnt lgkmcnt(0)" ::: "memory")

DI void transpose_items(const float* __restrict__ W, int K, int N, bf16_t* __restrict__ WT, int Npad, float* scr, int gw, int ngw, int lane) {
    const int nnb = Npad / 32, items = (K / 32) * nnb;
    for (int it = gw; it < items; it += ngw) {
        const int kb = it / nnb, nb = it % nnb, k0 = kb * 32, n0 = nb * 32;
#pragma unroll 4
        for (int i = 0; i < 16; ++i) {
            const int kk = 2 * i + (lane >> 5), n = n0 + (lane & 31);
            scr[kk * 33 + (lane & 31)] = (n < N) ? W[(size_t)(k0 + kk) * N + n] : 0.f;
        }
        LDS_FENCE();
#pragma unroll 4
        for (int j = 0; j < 16; ++j) {
            const int nn = 2 * j + (lane >> 5), kk = lane & 31;
            WT[(size_t)(n0 + nn) * K + k0 + kk] = f2bf(scr[kk * 33 + nn]);
        }
        LDS_FENCE();
    }
}

DI void rmsnorm_rows(const float* __restrict__ x, const float* __restrict__ gain, bf16_t* __restrict__ out, int gw, int ngw, int lane) {
    for (int row = gw; row < MTOK; row += ngw) {
        const f32x4* xr = (const f32x4*)(x + (size_t)row * DM) + lane;
        f32x4 v[4]; float ss = 0.f;
#pragma unroll
        for (int j = 0; j < 4; ++j) { v[j] = xr[64 * j]; ss += (v[j][0] * v[j][0] + v[j][1] * v[j][1]) + (v[j][2] * v[j][2] + v[j][3] * v[j][3]); }
        ss = wave_sum(ss);
        const float rinv = rsqrtf(ss * (1.f / DM) + RMS_EPS);
        u32x2* o = (u32x2*)(out + (size_t)row * DM) + lane;
#pragma unroll
        for (int j = 0; j < 4; ++j) {
            const f32x4 g = ((const f32x4*)gain)[lane + 64 * j];
            u32x2 w; w[0] = pk2(v[j][0] * rinv * g[0], v[j][1] * rinv * g[1]); w[1] = pk2(v[j][2] * rinv * g[2], v[j][3] * rinv * g[3]);
            o[64 * j] = w;
        }
    }
}

DI void phase_prep(const Args& a, int layer, unsigned char* smem) {
    int tid_ = threadIdx.x; asm volatile("" : "+v"(tid_)); const int tid = tid_, lane = tid & 63, wid = tid >> 6;
    const int gw = blockIdx.x * 8 + wid, ngw = gridDim.x * 8;
    float* scr = (float*)(smem + wid * 4352);
    unsigned char* ws = a.ws;
    transpose_items(a.in[2] + (size_t)layer * DM * DIN, DM, DIN, (bf16_t*)(ws + WS_WIN), NP, scr, gw, ngw, lane);
    transpose_items(a.in[16] + (size_t)layer * DM * DM, DM, DM, (bf16_t*)(ws + WS_WOUT), DM, scr, gw, ngw, lane);
    transpose_items(a.in[18] + (size_t)layer * DM * DFF, DM, DFF, (bf16_t*)(ws + WS_WUP), DFF, scr, gw, ngw, lane);
    transpose_items(a.in[19] + (size_t)layer * DFF * DM, DFF, DM, (bf16_t*)(ws + WS_WDOWN), DM, scr, gw, ngw, lane);
    transpose_items(a.in[11] + (size_t)layer * 192 * 384, 192, 384, (bf16_t*)(ws + WS_WUQ), 384, scr, gw, ngw, lane);
    transpose_items(a.in[12] + (size_t)layer * 128 * 512, 128, 512, (bf16_t*)(ws + WS_WUKV), 512, scr, gw, ngw, lane);
    if (layer == 0) {
        float* cosT = (float*)(ws + WS_ROPE); float* sinT = cosT + SEQ * 16;
        for (int idx = blockIdx.x * 512 + tid; idx < SEQ * 16; idx += gridDim.x * 512) {
            const int t = idx >> 4, i = idx & 15;
            const float inv = powf(10000.f, -(float)i * (1.f / 16.f));
            const float ang = (float)t * inv;
            const double kq = rint((double)ang * 0.15915494309189535);
            const float rf = (float)((double)ang - kq * 6.283185307179586);
            cosT[idx] = __cosf(rf); sinT[idx] = __sinf(rf);
        }
    }
    const float* x = (layer == 0) ? a.in[0] : a.out;
    rmsnorm_rows(x, a.in[1] + layer * DM, (bf16_t*)(ws + WS_XN), gw, ngw, lane);
}

struct EpiBf16 { bf16_t* O; int ldo;
    DI void operator()(int row, int col, f32x4 v) const { u32x2 w; w[0] = pk2(v[0], v[1]); w[1] = pk2(v[2], v[3]); *(u32x2*)(O + (size_t)row * ldo + col) = w; } };
struct EpiResid { const float* R; float* O;
    DI void operator()(int row, int col, f32x4 v) const { const size_t off = (size_t)row * DM + col; const f32x4 r = *(const f32x4*)(R + off); *(f32x4*)(O + off) = r + v; } };
struct EpiRelu2 { bf16_t* O;
    DI void operator()(int row, int col, f32x4 v) const {
        float t0 = fmaxf(v[0], 0.f), t1 = fmaxf(v[1], 0.f), t2 = fmaxf(v[2], 0.f), t3 = fmaxf(v[3], 0.f);
        u32x2 w; w[0] = pk2(t0 * t0, t1 * t1); w[1] = pk2(t2 * t2, t3 * t3); *(u32x2*)(O + (size_t)row * DFF + col) = w; } };

template <class Epi>
DI void gemm_simple(const bf16_t* __restrict__ A, int lda, const bf16_t* __restrict__ Bt, int ldb, int M, int N, int K, const Epi& E) {
    int tid_ = threadIdx.x; asm volatile("" : "+v"(tid_)); const int tid = tid_, lane = tid & 63, wid = tid >> 6, wr = wid >> 2, wc = wid & 3;
    const int nN = (N + 255) / 256, nunits = (M / 128) * nN;
    const int fr = lane & 15, fq = lane >> 4;
    for (int u = blockIdx.x; u < nunits; u += gridDim.x) {
        const int pm = u / nN, pn = u % nN;
        const int m0 = pm * 128 + wr * 64, n0 = pn * 256 + wc * 64;
        if (n0 >= N) continue;
        f32x4 acc[4][4];
#pragma unroll
        for (int i = 0; i < 4; ++i)
#pragma unroll
            for (int j = 0; j < 4; ++j) acc[i][j] = (f32x4){0.f, 0.f, 0.f, 0.f};
        const bf16_t* ap = A + (size_t)(m0 + fr) * lda + fq * 8;
        const bf16_t* bp = Bt + (size_t)(n0 + fr) * ldb + fq * 8;
#pragma unroll 2
        for (int k = 0; k < K; k += 32) {
            bf16x8 af[4], bfr[4];
#pragma unroll
            for (int i = 0; i < 4; ++i) af[i] = *(const bf16x8*)(ap + (size_t)(i * 16) * lda + k);
#pragma unroll
            for (int j = 0; j < 4; ++j) bfr[j] = *(const bf16x8*)(bp + (size_t)(j * 16) * ldb + k);
#pragma unroll
            for (int i = 0; i < 4; ++i)
#pragma unroll
                for (int j = 0; j < 4; ++j) acc[i][j] = mfma16(bfr[j], af[i], acc[i][j]);
        }
#pragma unroll
        for (int i = 0; i < 4; ++i)
#pragma unroll
            for (int j = 0; j < 4; ++j) E(m0 + i * 16 + fr, n0 + j * 16 + 4 * fq, acc[i][j]);
    }
}

DI void transpose_tile_to_vT(const bf16_t* __restrict__ src, int lds_, int colbase, int colstride_h, bf16_t* __restrict__ dstT, int t0, bf16_t* tile, int tid) {
    _Pragma("unroll 2") for (int e = tid; e < 64 * 32; e += 512) {
        const int r = e >> 5, ch = e & 31, h = ch >> 3, dc = ch & 7;
        const u32x4 v = *(const u32x4*)(src + (size_t)(t0 + r) * lds_ + colbase + h * colstride_h + dc * 8);
        *(u32x4*)(tile + r * 264 + ch * 8) = v;
    }
    __syncthreads();
    const int b = t0 >> 13, t = t0 & 8191;
    _Pragma("unroll 2") for (int e = tid; e < 256 * 8; e += 512) {
        const int hd = e >> 3, ch = e & 7;
        unsigned w[4];
#pragma unroll
        for (int j = 0; j < 4; ++j) w[j] = (unsigned)tile[(ch * 8 + 2 * j) * 264 + hd] | ((unsigned)tile[(ch * 8 + 2 * j + 1) * 264 + hd] << 16);
        u32x4 v; v[0] = w[0]; v[1] = w[1]; v[2] = w[2]; v[3] = w[3];
        *(u32x4*)(dstT + ((size_t)(b * 256 + hd)) * SEQ + t + ch * 8) = v;
    }
    __syncthreads();
}

DI void phase_post1(const Args& a, int layer, unsigned char* smem) {
    int tid_ = threadIdx.x; asm volatile("" : "+v"(tid_)); const int tid = tid_, lane = tid & 63, wid = tid >> 6;
    bf16_t* proj = (bf16_t*)(a.ws + WS_PROJ);
    const float* gq = a.in[6] + layer * 64; const float* gk = a.in[7] + layer * 64;
    const float* gcq = a.in[9] + layer * 192; const float* gckv = a.in[10] + layer * 128;
    for (int u = blockIdx.x; u < MTOK / 64; u += gridDim.x) {
        const int t0 = u * 64;
        for (int i = 0; i < 8; ++i) {
            bf16_t* p = proj + (size_t)(t0 + wid * 8 + i) * NP;
#pragma unroll
            for (int h = 0; h < 4; ++h) {
                float v = bf2f(p[C_DQ + h * 64 + lane]); float ss = wave_sum(v * v); float rinv = rsqrtf(ss * (1.f / 64.f) + RMS_EPS);
                p[C_DQ + h * 64 + lane] = f2bf(v * rinv * gq[lane] * DSA_QS);
                v = bf2f(p[C_DK + h * 64 + lane]); ss = wave_sum(v * v); rinv = rsqrtf(ss * (1.f / 64.f) + RMS_EPS);
                p[C_DK + h * 64 + lane] = f2bf(v * rinv * gk[lane]);
            }
            {
                const float c0 = bf2f(p[C_MCQ + lane]), c1 = bf2f(p[C_MCQ + 64 + lane]), c2 = bf2f(p[C_MCQ + 128 + lane]);
                const float ss = wave_sum(c0 * c0 + c1 * c1 + c2 * c2); const float rinv = rsqrtf(ss * (1.f / 192.f) + RMS_EPS);
                p[C_MCQ + lane] = f2bf(c0 * rinv * gcq[lane]); p[C_MCQ + 64 + lane] = f2bf(c1 * rinv * gcq[64 + lane]); p[C_MCQ + 128 + lane] = f2bf(c2 * rinv * gcq[128 + lane]);
            }
            {
                const float c0 = bf2f(p[C_MCKV + lane]), c1 = bf2f(p[C_MCKV + 64 + lane]);
                const float ss = wave_sum(c0 * c0 + c1 * c1); const float rinv = rsqrtf(ss * (1.f / 128.f) + RMS_EPS);
                p[C_MCKV + lane] = f2bf(c0 * rinv * gckv[lane]); p[C_MCKV + 64 + lane] = f2bf(c1 * rinv * gckv[64 + lane]);
            }
        }
        transpose_tile_to_vT(proj, NP, C_DV, 64, (bf16_t*)(a.ws + WS_VDT), t0, (bf16_t*)smem, tid);
    }
}

DI void phase_post2(const Args& a, int layer, unsigned char* smem) {
    int tid_ = threadIdx.x; asm volatile("" : "+v"(tid_)); const int tid = tid_, lane = tid & 63, wid = tid >> 6;
    const bf16_t* proj = (const bf16_t*)(a.ws + WS_PROJ);
    bf16_t* qm = (bf16_t*)(a.ws + WS_QM); bf16_t* km = (bf16_t*)(a.ws + WS_KM);
    const bf16_t* kvraw = (const bf16_t*)(a.ws + WS_MASK);
    const float* gqn = a.in[13] + layer * 96; const float* gkn = a.in[14] + layer * 96;
    const float* cosT = (const float*)(a.ws + WS_ROPE); const float* sinT = cosT + SEQ * 16;
    for (int u = blockIdx.x; u < MTOK / 64; u += gridDim.x) {
        const int t0 = u * 64;
        for (int i = 0; i < 8; ++i) {
            const int row = t0 + wid * 8 + i, t = row & 8191;
            const float cs = cosT[t * 16 + (lane & 15)], sn = sinT[t * 16 + (lane & 15)];
#pragma unroll
            for (int h = 0; h < 4; ++h) {
                {
                    bf16_t* q = qm + (size_t)row * 384 + h * 96;
                    float v0 = bf2f(q[lane]); float v1 = (lane < 32) ? bf2f(q[64 + lane]) : 0.f;
                    const float ss = wave_sum(v0 * v0 + v1 * v1); const float rinv = rsqrtf(ss * (1.f / 96.f) + RMS_EPS);
                    v0 = v0 * rinv * gqn[lane]; v1 = (lane < 32) ? v1 * rinv * gqn[64 + lane] : 0.f;
                    const float pr = __shfl_xor(v1, 16);
                    const float r1 = (lane < 16) ? (v1 * cs - pr * sn) : (v1 * cs + pr * sn);
                    q[lane] = f2bf(v0 * MLA_QS); if (lane < 32) q[64 + lane] = f2bf(r1 * MLA_QS);
                }
                {
                    float v0 = bf2f(kvraw[(size_t)row * 512 + h * 128 + lane]); float v1 = (lane < 32) ? bf2f(proj[(size_t)row * NP + C_MKR + lane]) : 0.f;
                    const float ss = wave_sum(v0 * v0 + v1 * v1); const float rinv = rsqrtf(ss * (1.f / 96.f) + RMS_EPS);
                    v0 = v0 * rinv * gkn[lane]; v1 = (lane < 32) ? v1 * rinv * gkn[64 + lane] : 0.f;
                    const float pr = __shfl_xor(v1, 16);
                    const float r1 = (lane < 16) ? (v1 * cs - pr * sn) : (v1 * cs + pr * sn);
                    bf16_t* k = km + (size_t)row * 384 + h * 96;
                    k[lane] = f2bf(v0); if (lane < 32) k[64 + lane] = f2bf(r1);
                }
            }
        }
        transpose_tile_to_vT(kvraw, 512, 64, 128, (bf16_t*)(a.ws + WS_VMT), t0, (bf16_t*)smem, tid);
    }
}

constexpr int GL_B = 0, GL_GLR = 16384, GL_GU = 20480, GL_BIAS = 24576, GL_QDEC = 24832, GL_KINV = 34048, GL_VT = 43264, GL_SPT = 61696, GL_SC = 80128, GL_O = 89344;
DI float logsig(float z) { return fminf(z, 0.f) - log1pf(expf(-fabsf(z))); }

DI void gla_stage_b(const Args& a, int layer, unsigned char* smem, int h, size_t row0) {
    int tid_ = threadIdx.x; asm volatile("" : "+v"(tid_)); const int tid = tid_;
    const bf16_t* proj = (const bf16_t*)(a.ws + WS_PROJ);
    float* bL = (float*)(smem + GL_B); float* glr = (float*)(smem + GL_GLR); float* gu = (float*)(smem + GL_GU); float* bias = (float*)(smem + GL_BIAS);
    const float* gup = a.in[3] + (size_t)layer * 16 * 256; const float* gb = a.in[4] + layer * 256;
    _Pragma("unroll 2") for (int e = tid; e < 1024; e += 512) { const int c = e >> 4, r = e & 15; glr[e] = bf2f(proj[(row0 + c) * NP + C_GLR + r]); }
    _Pragma("unroll 2") for (int e = tid; e < 1024; e += 512) { const int r = e >> 6, d = e & 63; gu[e] = gup[r * 256 + h * 64 + d]; }
    if (tid < 64) bias[tid] = gb[h * 64 + tid];
    __syncthreads();
    _Pragma("unroll 2") for (int e = tid; e < 4096; e += 512) {
        const int c = e >> 6, d = e & 63; float z = bias[d];
#pragma unroll
        for (int r = 0; r < 16; ++r) z = fmaf(glr[c * 16 + r], gu[r * 64 + d], z);
        bL[e] = logsig(z) * (1.f / 16.f);
    }
    __syncthreads();
    if (tid < 64) { float run = 0.f; for (int c = 0; c < 64; ++c) { run += bL[c * 64 + tid]; bL[c * 64 + tid] = run; } }
    __syncthreads();
}

DI void phase_gla1(const Args& a, int layer, unsigned char* smem) {
    int tid_ = threadIdx.x; asm volatile("" : "+v"(tid_)); const int tid = tid_, lane = tid & 63, wid = tid >> 6;
    const bf16_t* proj = (const bf16_t*)(a.ws + WS_PROJ);
    float* G = (float*)(a.ws + WS_GLA); float* dec = (float*)(a.ws + WS_GDEC);
    float* bL = (float*)(smem + GL_B); bf16_t* kendT = (bf16_t*)(smem + GL_KINV); bf16_t* VT = (bf16_t*)(smem + GL_VT);
    for (int u = blockIdx.x; u < 1024; u += gridDim.x) {
        const int bh = u >> 7, n = u & 127, b = bh >> 2, h = bh & 3;
        const size_t row0 = (size_t)b * SEQ + n * 64;
        gla_stage_b(a, layer, smem, h, row0);
        _Pragma("unroll 2") for (int e = tid; e < 4096; e += 512) {
            const int c = e >> 6, d = e & 63;
            const float k = bf2f(proj[(row0 + c) * NP + C_GK + h * 64 + d]);
            kendT[d * 72 + c] = f2bf(k * expf(bL[63 * 64 + d] - bL[c * 64 + d]));
        }
        _Pragma("unroll 2") for (int e = tid; e < 8192; e += 512) { const int c = e >> 7, v = e & 127; VT[v * 72 + c] = proj[(row0 + c) * NP + C_GV + h * 128 + v]; }
        if (tid < 64) dec[(size_t)u * 64 + tid] = expf(bL[63 * 64 + tid]);
        __syncthreads();
#pragma unroll
        for (int i = 0; i < 4; ++i) {
            const int tile = wid * 4 + i, tv = tile >> 2, td = tile & 3;
            f32x4 acc = {0.f, 0.f, 0.f, 0.f};
#pragma unroll
            for (int ks = 0; ks < 2; ++ks) {
                const bf16x8 av = *(const bf16x8*)(VT + (tv * 16 + (lane & 15)) * 72 + ks * 32 + 8 * (lane >> 4));
                const bf16x8 bv = *(const bf16x8*)(kendT + (td * 16 + (lane & 15)) * 72 + ks * 32 + 8 * (lane >> 4));
                acc = mfma16(av, bv, acc);
            }
#pragma unroll
            for (int r = 0; r < 4; ++r) G[((size_t)u * 128 + tv * 16 + 4 * (lane >> 4) + r) * 64 + td * 16 + (lane & 15)] = acc[r];
        }
        __syncthreads();
    }
}

DI void phase_gla2(const Args& a) {
    float* G = (float*)(a.ws + WS_GLA); const float* dec = (const float*)(a.ws + WS_GDEC);
    for (int e = blockIdx.x * 512 + threadIdx.x; e < 65536; e += gridDim.x * 512) {
        const int bh = e >> 13, vd = e & 8191, d = e & 63;
        float st = 0.f;
        for (int n0 = 0; n0 < 128; n0 += 8) {
            float inc[8], dc[8];
#pragma unroll
            for (int j = 0; j < 8; ++j) { const size_t un = (size_t)bh * 128 + n0 + j; inc[j] = G[un * 8192 + vd]; dc[j] = dec[un * 64 + d]; }
#pragma unroll
            for (int j = 0; j < 8; ++j) { const size_t un = (size_t)bh * 128 + n0 + j; G[un * 8192 + vd] = st; st = fmaf(dc[j], st, inc[j]); }
        }
    }
}

DI void phase_gla3(const Args& a, int layer, unsigned char* smem) {
    int tid_ = threadIdx.x; asm volatile("" : "+v"(tid_)); const int tid = tid_, lane = tid & 63, wid = tid >> 6;
    const bf16_t* proj = (const bf16_t*)(a.ws + WS_PROJ);
    const float* G = (const float*)(a.ws + WS_GLA);
    bf16_t* mix = (bf16_t*)(a.ws + WS_XN);
    const float* gnorm = a.in[5] + layer * 512;
    float* bL = (float*)(smem + GL_B); bf16_t* qdec = (bf16_t*)(smem + GL_QDEC); bf16_t* kinv = (bf16_t*)(smem + GL_KINV); bf16_t* VT = (bf16_t*)(smem + GL_VT);
    bf16_t* SpT = (bf16_t*)(smem + GL_SPT); bf16_t* sc = (bf16_t*)(smem + GL_SC); float* oL = (float*)(smem + GL_O);
    for (int u = blockIdx.x; u < 1024; u += gridDim.x) {
        const int bh = u >> 7, n = u & 127, b = bh >> 2, h = bh & 3;
        const size_t row0 = (size_t)b * SEQ + n * 64;
        gla_stage_b(a, layer, smem, h, row0);
        _Pragma("unroll 2") for (int e = tid; e < 4096; e += 512) {
            const int c = e >> 6, d = e & 63; const float bb = bL[e];
            const float q = bf2f(proj[(row0 + c) * NP + C_GQ + h * 64 + d]), k = bf2f(proj[(row0 + c) * NP + C_GK + h * 64 + d]);
            qdec[c * 72 + d] = f2bf(q * 0.125f * expf(bb)); kinv[c * 72 + d] = f2bf(k * expf(-bb));
        }
        _Pragma("unroll 2") for (int e = tid; e < 8192; e += 512) { const int c = e >> 7, v = e & 127; VT[v * 72 + c] = proj[(row0 + c) * NP + C_GV + h * 128 + v]; }
        _Pragma("unroll 2") for (int e = tid; e < 8192; e += 512) { const int v = e >> 6, d = e & 63; SpT[v * 72 + d] = f2bf(G[(size_t)u * 8192 + e]); }
        _Pragma("unroll 2") for (int e = tid; e < 64 * 72 / 2; e += 512) ((unsigned*)sc)[e] = 0u;
        __syncthreads();
        for (int idx = wid; idx < 10; idx += 8) {
            int tc = 0, rem = idx; while (rem > tc) { rem -= tc + 1; ++tc; } const int ts = rem;
            f32x4 acc = {0.f, 0.f, 0.f, 0.f};
#pragma unroll
            for (int ks = 0; ks < 2; ++ks) {
                const bf16x8 av = *(const bf16x8*)(qdec + (tc * 16 + (lane & 15)) * 72 + ks * 32 + 8 * (lane >> 4));
                const bf16x8 bv = *(const bf16x8*)(kinv + (ts * 16 + (lane & 15)) * 72 + ks * 32 + 8 * (lane >> 4));
                acc = mfma16(av, bv, acc);
            }
            const int s = ts * 16 + (lane & 15);
#pragma unroll
            for (int r = 0; r < 4; ++r) { const int c = tc * 16 + 4 * (lane >> 4) + r; sc[c * 72 + s] = f2bf((s <= c) ? acc[r] : 0.f); }
        }
        __syncthreads();
#pragma unroll
        for (int i = 0; i < 4; ++i) {
            const int tile = wid * 4 + i, tc = tile >> 3, tv = tile & 7;
            f32x4 acc = {0.f, 0.f, 0.f, 0.f};
#pragma unroll
            for (int ks = 0; ks < 2; ++ks) {
                const bf16x8 av = *(const bf16x8*)(sc + (tc * 16 + (lane & 15)) * 72 + ks * 32 + 8 * (lane >> 4));
                const bf16x8 bv = *(const bf16x8*)(VT + (tv * 16 + (lane & 15)) * 72 + ks * 32 + 8 * (lane >> 4));
                acc = mfma16(av, bv, acc);
            }
#pragma unroll
            for (int ks = 0; ks < 2; ++ks) {
                const bf16x8 av = *(const bf16x8*)(qdec + (tc * 16 + (lane & 15)) * 72 + ks * 32 + 8 * (lane >> 4));
                const bf16x8 bv = *(const bf16x8*)(SpT + (tv * 16 + (lane & 15)) * 72 + ks * 32 + 8 * (lane >> 4));
                acc = mfma16(av, bv, acc);
            }
#pragma unroll
            for (int r = 0; r < 4; ++r) oL[(tc * 16 + 4 * (lane >> 4) + r) * 132 + tv * 16 + (lane & 15)] = acc[r];
        }
        __syncthreads();
        {
            const int c = tid >> 3, sub = tid & 7;
            float ov[16]; float ss = 0.f;
#pragma unroll
            for (int j = 0; j < 16; ++j) { ov[j] = oL[c * 132 + sub * 16 + j]; ss += ov[j] * ov[j]; }
            ss += __shfl_xor(ss, 1); ss += __shfl_xor(ss, 2); ss += __shfl_xor(ss, 4);
            const float rinv = rsqrtf(ss * (1.f / 128.f) + RMS_EPS);
            const bf16_t* gp = proj + (row0 + c) * NP + C_GG + h * 128 + sub * 16;
            bf16_t* mp = mix + (row0 + c) * DM + h * 128 + sub * 16;
            unsigned w[8];
#pragma unroll
            for (int j = 0; j < 16; j += 2) {
                const float g0 = bf2f(gp[j]), g1 = bf2f(gp[j + 1]);
                const float s0 = g0 / (1.f + expf(-g0)), s1 = g1 / (1.f + expf(-g1));
                w[j >> 1] = pk2(ov[j] * rinv * gnorm[h * 128 + sub * 16 + j] * s0, ov[j + 1] * rinv * gnorm[h * 128 + sub * 16 + j + 1] * s1);
            }
            u32x4 w0, w1; w0[0] = w[0]; w0[1] = w[1]; w0[2] = w[2]; w0[3] = w[3]; w1[0] = w[4]; w1[1] = w[5]; w1[2] = w[6]; w1[3] = w[7];
            *(u32x4*)mp = w0; *(u32x4*)(mp + 8) = w1;
        }
        __syncthreads();
    }
}

DI unsigned fkey(float s) { const unsigned u = __float_as_uint(s); return (u & 0x80000000u) ? ~u : (u | 0x80000000u); }
DI void dsa_scores(bf16x8 ka, const bf16x8 (&bq)[8], const float (&w)[8], float (&sc)[4]) {
    const f32x4 z = {0.f, 0.f, 0.f, 0.f};
    sc[0] = 0.f; sc[1] = 0.f; sc[2] = 0.f; sc[3] = 0.f;
#pragma unroll
    for (int h = 0; h < 8; ++h) {
        const f32x4 d = mfma16(ka, bq[h], z);
#pragma unroll
        for (int r = 0; r < 4; ++r) sc[r] = __builtin_fmaf(w[h], fmaxf(d[r], 0.f), sc[r]);
    }
#pragma unroll
    for (int r = 0; r < 4; ++r) sc[r] += 0.0f;
}

DI void phase_dsa_select(const Args& a, unsigned char* smem) {
    int tid_ = threadIdx.x; asm volatile("" : "+v"(tid_)); const int tid = tid_, lane = tid & 63, wid = tid >> 6;
    const bf16_t* proj = (const bf16_t*)(a.ws + WS_PROJ);
    unsigned* mask = (unsigned*)(a.ws + WS_MASK);
    unsigned* hist = (unsigned*)smem;
    unsigned* maskL = (unsigned*)smem; unsigned long long* cand = (unsigned long long*)(smem + 16384);
    int* sel = (int*)(smem + 131072); int* cnt = sel + 64;
    const int qrow = lane & 15, kq = lane >> 4;
    for (int u = blockIdx.x; u < 1024; u += gridDim.x) {
        const int b = u & 1, t0 = (511 - (u >> 1)) * 16;
        const size_t g0 = (size_t)b * SEQ + t0;
        unsigned* gmask = mask + g0 * 256;
        if (t0 < 256) {
            _Pragma("unroll 2") for (int e = tid; e < 4096; e += 512) {
                const int r = e >> 8, j = e & 255, t = t0 + r; unsigned w;
                if (32 * j + 31 <= t) w = 0xFFFFFFFFu; else if (32 * j > t) w = 0u; else w = (2u << (t - 32 * j)) - 1u;
                gmask[e] = w;
            }
            continue;
        }
        const bf16_t* qp = proj + (g0 + qrow) * NP;
        bf16x8 bq[8]; float w[8];
#pragma unroll
        for (int h = 0; h < 8; ++h) { bq[h] = *(const bf16x8*)(qp + C_IQ + h * 32 + kq * 8); w[h] = bf2f(qp[C_IW + h]) * 0.0625f; }
        const int tq = t0 + qrow, nkt = t0 / 16 + 1;
        const bf16_t* kbase = proj + ((size_t)b * SEQ + qrow) * NP + C_IK + kq * 8;
        _Pragma("unroll 2") for (int e = tid; e < 16 * 2048; e += 512) hist[e] = 0u;
        __syncthreads();
        for (int kt = wid; kt < nkt; kt += 8) {
            const bf16x8 ka = *(const bf16x8*)(kbase + (size_t)(kt * 16) * NP);
            float sc[4]; dsa_scores(ka, bq, w, sc);
#pragma unroll
            for (int r = 0; r < 4; ++r) {
                const int kp = kt * 16 + kq * 4 + r;
                if (kp <= tq) { const unsigned bin = fkey(sc[r]) >> 20; atomicAdd(&hist[qrow * 2048 + (bin >> 1)], 1u << ((bin & 1) * 16)); }
            }
        }
        __syncthreads();
        for (int rr = 0; rr < 2; ++rr) {
            const int row = wid * 2 + rr; const unsigned* hrow = hist + row * 2048;
            unsigned c = 0;
            for (int i = 0; i < 32; ++i) { const unsigned wv = hrow[lane * 32 + i]; c += (wv & 0xFFFFu) + (wv >> 16); }
            unsigned incl = c;
#pragma unroll
            for (int off = 1; off < 64; off <<= 1) { const unsigned o = __shfl_down(incl, off); if (lane + off < 64) incl += o; }
            const unsigned above = incl - c;
            if (above < 256u && incl >= 256u) {
                unsigned run = above; int bst = lane * 64; unsigned ca = above;
                for (int bin = lane * 64 + 63; bin >= lane * 64; --bin) {
                    const unsigned wv = hrow[bin >> 1]; const unsigned cn = (bin & 1) ? (wv >> 16) : (wv & 0xFFFFu);
                    if (run + cn >= 256u) { bst = bin; ca = run; break; }
                    run += cn;
                }
                sel[row * 2] = bst; sel[row * 2 + 1] = (int)ca;
            }
        }
        __syncthreads();
        const int bst_l = sel[qrow * 2];
        __syncthreads();
        _Pragma("unroll 2") for (int e = tid; e < 4096; e += 512) maskL[e] = 0u;
        if (tid < 16) cnt[tid] = 0;
        __syncthreads();
        for (int kt = wid; kt < nkt; kt += 8) {
            const bf16x8 ka = *(const bf16x8*)(kbase + (size_t)(kt * 16) * NP);
            float sc[4]; dsa_scores(ka, bq, w, sc);
            unsigned bits = 0u;
#pragma unroll
            for (int r = 0; r < 4; ++r) {
                const int kp = kt * 16 + kq * 4 + r;
                if (kp <= tq) {
                    const unsigned key = fkey(sc[r]); const int bin = (int)(key >> 20);
                    if (bin > bst_l) bits |= 1u << r;
                    else if (bin == bst_l) { const int pos = atomicAdd(&cnt[qrow], 1); if (pos < CAND_CAP) cand[qrow * CAND_CAP + pos] = ((unsigned long long)key << 32) | (unsigned long long)(0xFFFFFFFFu - (unsigned)kp); }
                }
            }
            if (bits) atomicOr(&maskL[qrow * 256 + (kt >> 1)], bits << ((kt & 1) * 16 + kq * 4));
        }
        __syncthreads();
        for (int rr = 0; rr < 2; ++rr) {
            const int row = wid * 2 + rr; const int n = min(cnt[row], CAND_CAP); const int need = 256 - sel[row * 2 + 1];
            for (int i = lane; i < n; i += 64) {
                const unsigned long long ci = cand[row * CAND_CAP + i]; int rank = 0;
                for (int m = 0; m < n; ++m) rank += (cand[row * CAND_CAP + m] > ci) ? 1 : 0;
                if (rank < need) { const unsigned kp = 0xFFFFFFFFu - (unsigned)(ci & 0xFFFFFFFFull); atomicOr(&maskL[row * 256 + (kp >> 5)], 1u << (kp & 31)); }
            }
        }
        __syncthreads();
        _Pragma("unroll 2") for (int e = tid; e < 4096; e += 512) gmask[e] = maskL[e];
        __syncthreads();
    }
}

template <int DQ, bool USE_MASK>
DI void attn_wave(const bf16_t* __restrict__ Q, int ldq, int qcol, const bf16_t* __restrict__ K, int ldk, int kcol, const bf16_t* __restrict__ VTb,
                  const unsigned* __restrict__ mask, int b, int qb, int lane, bf16_t* __restrict__ mix, int mixcol, const float* __restrict__ gain) {
    const int r32 = lane & 31, hi = lane >> 5;
    const size_t rb = (size_t)b * SEQ; const int q0 = qb * 32;
    constexpr int NS = DQ / 16;
    bf16x8 qf[NS];
#pragma unroll
    for (int s = 0; s < NS; ++s) qf[s] = *(const bf16x8*)(Q + (rb + q0 + r32) * ldq + qcol + 16 * s + 8 * hi);
    f32x16 o0, o1;
#pragma unroll
    for (int r = 0; r < 16; ++r) { o0[r] = 0.f; o1[r] = 0.f; }
    float m = -1e30f, l = 0.f;
    const unsigned* mrow = mask + (rb + q0 + r32) * 256;
    for (int kt = 0; kt <= qb; ++kt) {
        f32x16 p;
#pragma unroll
        for (int r = 0; r < 16; ++r) p[r] = 0.f;
        const bf16_t* kp = K + (rb + kt * 32 + r32) * ldk + kcol + 8 * hi;
#pragma unroll
        for (int s = 0; s < NS; ++s) { const bf16x8 kf = *(const bf16x8*)(kp + 16 * s); p = mfma32(kf, qf[s], p); }
        unsigned vbits;
        if (USE_MASK) vbits = mrow[kt];
        else vbits = (kt < qb) ? 0xFFFFFFFFu : ((2u << r32) - 1u);
        float pm = -1e30f;
#pragma unroll
        for (int r = 0; r < 16; ++r) { const bool v = (vbits >> crow(r, hi)) & 1u; pm = fmaxf(pm, v ? p[r] : -1e30f); }
        pm = fmaxf(pm, __shfl_xor(pm, 32));
        const float mn = fmaxf(m, pm); const float alpha = __builtin_amdgcn_exp2f(m - mn); m = mn;
        float ls = 0.f;
#pragma unroll
        for (int r = 0; r < 16; ++r) { const bool v = (vbits >> crow(r, hi)) & 1u; const float e = v ? __builtin_amdgcn_exp2f(p[r] - mn) : 0.f; p[r] = e; ls += e; }
        l = l * alpha + ls;
#pragma unroll
        for (int r = 0; r < 16; ++r) { o0[r] *= alpha; o1[r] *= alpha; }
        bf16x8 pk[2];
#pragma unroll
        for (int s = 0; s < 2; ++s) {
            u32x4 w; w[0] = pk2(p[8 * s], p[8 * s + 1]); w[1] = pk2(p[8 * s + 2], p[8 * s + 3]); w[2] = pk2(p[8 * s + 4], p[8 * s + 5]); w[3] = pk2(p[8 * s + 6], p[8 * s + 7]);
            pk[s] = __builtin_bit_cast(bf16x8, w);
        }
#pragma unroll
        for (int s = 0; s < 2; ++s) {
            const bf16_t* v0p = VTb + (size_t)r32 * SEQ + kt * 32 + 16 * s + 4 * hi;
            const bf16_t* v1p = v0p + (size_t)32 * SEQ;
            const u32x2 a0 = *(const u32x2*)v0p, a1 = *(const u32x2*)(v0p + 8);
            const u32x2 c0 = *(const u32x2*)v1p, c1 = *(const u32x2*)(v1p + 8);
            u32x4 f0, f1; f0[0] = a0[0]; f0[1] = a0[1]; f0[2] = a1[0]; f0[3] = a1[1]; f1[0] = c0[0]; f1[1] = c0[1]; f1[2] = c1[0]; f1[3] = c1[1];
            o0 = mfma32(__builtin_bit_cast(bf16x8, f0), pk[s], o0);
            o1 = mfma32(__builtin_bit_cast(bf16x8, f1), pk[s], o1);
        }
    }
    l += __shfl_xor(l, 32);
    const float linv = 1.f / l;
    float ss = 0.f;
#pragma unroll
    for (int r = 0; r < 16; ++r) { o0[r] *= linv; o1[r] *= linv; ss += o0[r] * o0[r] + o1[r] * o1[r]; }
    ss += __shfl_xor(ss, 32);
    const float rinv = rsqrtf(ss * (1.f / 64.f) + RMS_EPS);
    bf16_t* mp = mix + (rb + q0 + r32) * DM + mixcol;
#pragma unroll
    for (int g = 0; g < 4; ++g) {
        const int d0 = 8 * g + 4 * hi;
        u32x2 w;
        w[0] = pk2(o0[4 * g] * rinv * gain[d0], o0[4 * g + 1] * rinv * gain[d0 + 1]); w[1] = pk2(o0[4 * g + 2] * rinv * gain[d0 + 2], o0[4 * g + 3] * rinv * gain[d0 + 3]);
        *(u32x2*)(mp + d0) = w;
        w[0] = pk2(o1[4 * g] * rinv * gain[32 + d0], o1[4 * g + 1] * rinv * gain[32 + d0 + 1]); w[1] = pk2(o1[4 * g + 2] * rinv * gain[32 + d0 + 2], o1[4 * g + 3] * rinv * gain[32 + d0 + 3]);
        *(u32x2*)(mp + 32 + d0) = w;
    }
}

DI void phase_attn_mla(const Args& a, int layer) {
    const int lane = threadIdx.x & 63, wid = threadIdx.x >> 6;
    const bf16_t* qm = (const bf16_t*)(a.ws + WS_QM); const bf16_t* km = (const bf16_t*)(a.ws + WS_KM); const bf16_t* vmT = (const bf16_t*)(a.ws + WS_VMT);
    bf16_t* mix = (bf16_t*)(a.ws + WS_XN);
    for (int u = blockIdx.x * 8 + wid; u < 2048; u += gridDim.x * 8) {
        const int kk = u >> 3, w = u & 7, b = w >> 2, h = w & 3, qb = 255 - ((kk + 32 * w) & 255);
        attn_wave<96, false>(qm, 384, h * 96, km, 384, h * 96, vmT + (size_t)(w * 64) * SEQ, (const unsigned*)(a.ws + WS_MASK), b, qb, lane, mix, 768 + h * 64, a.in[15] + layer * 256 + h * 64);
    }
}
DI void phase_attn_dsa(const Args& a, int layer) {
    const int lane = threadIdx.x & 63, wid = threadIdx.x >> 6;
    const bf16_t* proj = (const bf16_t*)(a.ws + WS_PROJ); const bf16_t* vdT = (const bf16_t*)(a.ws + WS_VDT);
    bf16_t* mix = (bf16_t*)(a.ws + WS_XN);
    for (int u = blockIdx.x * 8 + wid; u < 2048; u += gridDim.x * 8) {
        const int kk = u >> 3, w = u & 7, b = w >> 2, h = w & 3, qb = 255 - ((kk + 32 * w) & 255);
        attn_wave<64, true>(proj, NP, C_DQ + h * 64, proj, NP, C_DK + h * 64, vdT + (size_t)(w * 64) * SEQ, (const unsigned*)(a.ws + WS_MASK), b, qb, lane, mix, 512 + h * 64, a.in[8] + layer * 256 + h * 64);
    }
}

__global__ void __launch_bounds__(512, 2) fwd_kernel(Args a) {
    extern __shared__ __attribute__((aligned(16))) unsigned char smem[];
    cg::grid_group grid = cg::this_grid();
    unsigned char* ws = a.ws;
    const int lane = threadIdx.x & 63, wid = threadIdx.x >> 6;
    for (int ph = a.ph_lo; ph < a.ph_hi; ++ph) {
        const int layer = ph / NPH, p = ph % NPH;
        asm volatile("" : "+s"(ws));
        switch (p) {
        case 0: phase_prep(a, layer, smem); break;
        case 1: { EpiBf16 E{(bf16_t*)(ws + WS_PROJ), NP}; gemm_simple((const bf16_t*)(ws + WS_XN), DM, (const bf16_t*)(ws + WS_WIN), DM, MTOK, NP, DM, E); } break;
        case 2: phase_post1(a, layer, smem); break;
        case 3: {
            EpiBf16 E1{(bf16_t*)(ws + WS_QM), 384}; gemm_simple((const bf16_t*)(ws + WS_PROJ) + C_MCQ, NP, (const bf16_t*)(ws + WS_WUQ), 192, MTOK, 384, 192, E1);
            EpiBf16 E2{(bf16_t*)(ws + WS_MASK), 512}; gemm_simple((const bf16_t*)(ws + WS_PROJ) + C_MCKV, NP, (const bf16_t*)(ws + WS_WUKV), 128, MTOK, 512, 128, E2);
        } break;
        case 4: phase_post2(a, layer, smem); break;
        case 5: phase_gla1(a, layer, smem); phase_dsa_select(a, smem); phase_attn_mla(a, layer); break;
        case 6: phase_gla2(a); phase_attn_dsa(a, layer); break;
        case 7: phase_gla3(a, layer, smem); break;
        case 8: { EpiResid E{layer == 0 ? a.in[0] : a.out, a.out}; gemm_simple((const bf16_t*)(ws + WS_XN), DM, (const bf16_t*)(ws + WS_WOUT), DM, MTOK, DM, DM, E); } break;
        case 9: rmsnorm_rows(a.out, a.in[17] + layer * DM, (bf16_t*)(ws + WS_XN), blockIdx.x * 8 + wid, gridDim.x * 8, lane); break;
        case 10: { EpiRelu2 E{(bf16_t*)(ws + WS_U)}; gemm_simple((const bf16_t*)(ws + WS_XN), DM, (const bf16_t*)(ws + WS_WUP), DM, MTOK, DFF, DM, E); } break;
        case 11: { EpiResid E{a.out, a.out}; gemm_simple((const bf16_t*)(ws + WS_U), DFF, (const bf16_t*)(ws + WS_WDOWN), DFF, MTOK, DM, DFF, E); } break;
        }
        if (ph + 1 < a.ph_hi) grid.sync();
    }
}

extern "C" void kernel_launch(void* const* d_in, const int* in_sizes, int n_in, void* d_out, int out_size, void* d_ws, size_t ws_size, hipStream_t stream) {
    static int grid_blocks = 0;
    if (grid_blocks == 0) {
        if (n_in != 20 || ws_size < WS_END) { fprintf(stderr, "kernel_launch: unexpected n_in %d / ws_size %zu\n", n_in, ws_size); grid_blocks = -1; return; }
        int dev = 0, cus = 0, per_cu = 0;
        hipGetDevice(&dev);
        hipDeviceGetAttribute(&cus, hipDeviceAttributeMultiprocessorCount, dev);
        hipFuncSetAttribute((const void*)fwd_kernel, hipFuncAttributeMaxDynamicSharedMemorySize, LDS_BYTES);
        hipOccupancyMaxActiveBlocksPerMultiprocessor(&per_cu, (const void*)fwd_kernel, 512, LDS_BYTES);
        if (per_cu < 1) { fprintf(stderr, "kernel_launch: occupancy query says %d blocks/CU\n", per_cu); per_cu = 1; }
        if (per_cu > 1) per_cu = 1;
        grid_blocks = cus * per_cu;
        (void)hipGetLastError();
    }
    if (grid_blocks < 0) return;
    Args a{};
    for (int i = 0; i < 20; ++i) a.in[i] = (const float*)d_in[i];
    a.out = (float*)d_out; a.ws = (unsigned char*)d_ws;
#if N_LAUNCH_MODE == 1
    a.ph_lo = 0; a.ph_hi = 2 * NPH;
    void* args[] = {&a};
    hipError_t e = hipLaunchCooperativeKernel((const void*)fwd_kernel, dim3(grid_blocks), dim3(512), args, LDS_BYTES, stream);
    if (e != hipSuccess) fprintf(stderr, "cooperative launch failed: %s (grid %d)\n", hipGetErrorString(e), grid_blocks);
#else
    for (int ph = 0; ph < 2 * NPH; ++ph) {
        a.ph_lo = ph; a.ph_hi = ph + 1;
        hipLaunchKernelGGL(fwd_kernel, dim3(grid_blocks), dim3(512), LDS_BYTES, stream, a);
    }
#endif
}
```

```cpp
#include <hip/hip_runtime.h>
#include <hip/hip_cooperative_groups.h>
#include <cstdio>
#include <cstdint>
namespace cg = cooperative_groups;

#ifndef N_LAUNCH_MODE
#define N_LAUNCH_MODE 1
#endif

#define DI __device__ __forceinline__
typedef unsigned short bf16_t;
typedef short bf16x8 __attribute__((ext_vector_type(8)));
typedef short bf16x4 __attribute__((ext_vector_type(4)));
typedef float f32x4 __attribute__((ext_vector_type(4)));
typedef float f32x16 __attribute__((ext_vector_type(16)));
typedef unsigned u32x4 __attribute__((ext_vector_type(4)));
typedef unsigned u32x2 __attribute__((ext_vector_type(2)));

constexpr int SEQ = 8192, MTOK = 16384, DM = 1024, NP = 3072, DIN = 2968, DFF = 4096;
constexpr int C_GQ = 0, C_GK = 256, C_GV = 512, C_GG = 1024, C_GLR = 1536, C_DQ = 1552, C_DK = 1808, C_DV = 2064,
              C_IQ = 2320, C_IK = 2576, C_IW = 2608, C_MCQ = 2616, C_MCKV = 2808, C_MKR = 2936;
constexpr float RMS_EPS = 1e-6f;
constexpr float LOG2E = 1.4426950408889634f;
constexpr float DSA_QS = 0.125f * LOG2E;
constexpr float MLA_QS = 0.10206207261596577f * LOG2E;
constexpr int NPH = 12;
constexpr int LDS_BYTES = 147456;
constexpr int CAND_CAP = 768;

constexpr size_t MiB = 1u << 20;
constexpr size_t WS_WIN = 1 * MiB, WS_WOUT = 7 * MiB, WS_WUP = 9 * MiB, WS_WDOWN = 17 * MiB, WS_WUQ = 25 * MiB, WS_WUKV = 25 * MiB + 256 * 1024;
constexpr size_t WS_ROPE = 26 * MiB;
constexpr size_t WS_XN = 27 * MiB;
constexpr size_t WS_PROJ = 59 * MiB;
constexpr size_t WS_GLA = 155 * MiB;
constexpr size_t WS_U = 59 * MiB;
constexpr size_t WS_GDEC = 187 * MiB;
constexpr size_t WS_MASK = 188 * MiB;
constexpr size_t WS_VDT = 204 * MiB;
constexpr size_t WS_QM = 212 * MiB;
constexpr size_t WS_KM = 224 * MiB;
constexpr size_t WS_VMT = 236 * MiB;
constexpr size_t WS_END = 244 * MiB;

struct Args { const float* in[20]; float* out; unsigned char* ws; int ph_lo, ph_hi; };

DI float bf2f(bf16_t v) { return __uint_as_float((unsigned)v << 16); }
DI bf16_t f2bf(float f) { unsigned u = __float_as_uint(f); return (bf16_t)((u + 0x7fffu + ((u >> 16) & 1u)) >> 16); }
DI unsigned pk2(float lo, float hi) { return (unsigned)f2bf(lo) | ((unsigned)f2bf(hi) << 16); }
DI f32x4 mfma16(bf16x8 a, bf16x8 b, f32x4 c) { return __builtin_amdgcn_mfma_f32_16x16x32_bf16(a, b, c, 0, 0, 0); }
DI f32x16 mfma32(bf16x8 a, bf16x8 b, f32x16 c) { return __builtin_amdgcn_mfma_f32_32x32x16_bf16(a, b, c, 0, 0, 0); }
DI float wave_sum(float v) {
#pragma unroll
    for (int o = 1; o < 64; o <<= 1) v += __shfl_xor(v, o);
    return v;
}
DI int crow(int r, int hi) { return (r & 3) + 8 * (r >> 2) + 4 * hi; }
#define LDS_FENCE() asm volatile("s_waitcnt lgkmcnt(0)" ::: "memory")

DI void transpose_items(const float* __restrict__ W, int K, int N, bf16_t* __restrict__ WT, int Npad, float* scr, int gw, int ngw, int lane) {
    const int nnb = Npad / 32, items = (K / 32) * nnb;
    for (int it = gw; it < items; it += ngw) {
        const int kb = it / nnb, nb = it % nnb, k0 = kb * 32, n0 = nb * 32;
#pragma unroll 4
        for (int i = 0; i < 16; ++i) {
            const int kk = 2 * i + (lane >> 5), n = n0 + (lane & 31);
            scr[kk * 33 + (lane & 31)] = (n < N) ? W[(size_t)(k0 + kk) * N + n] : 0.f;
        }
        LDS_FENCE();
#pragma unroll 4
        for (int j = 0; j < 16; ++j) {
            const int nn = 2 * j + (lane >> 5), kk = lane & 31;
            WT[(size_t)(n0 + nn) * K + k0 + kk] = f2bf(scr[kk * 33 + nn]);
        }
        LDS_FENCE();
    }
}

DI void rmsnorm_rows(const float* __restrict__ x, const float* __restrict__ gain, bf16_t* __restrict__ out, int gw, int ngw, int lane) {
    for (int row = gw; row < MTOK; row += ngw) {
        const f32x4* xr = (const f32x4*)(x + (size_t)row * DM) + lane;
        f32x4 v[4]; float ss = 0.f;
#pragma unroll
        for (int j = 0; j < 4; ++j) { v[j] = xr[64 * j]; ss += (v[j][0] * v[j][0] + v[j][1] * v[j][1]) + (v[j][2] * v[j][2] + v[j][3] * v[j][3]); }
        ss = wave_sum(ss);
        const float rinv = rsqrtf(ss * (1.f / DM) + RMS_EPS);
        u32x2* o = (u32x2*)(out + (size_t)row * DM) + lane;
#pragma unroll
        for (int j = 0; j < 4; ++j) {
            const f32x4 g = ((const f32x4*)gain)[lane + 64 * j];
            u32x2 w; w[0] = pk2(v[j][0] * rinv * g[0], v[j][1] * rinv * g[1]); w[1] = pk2(v[j][2] * rinv * g[2], v[j][3] * rinv * g[3]);
            o[64 * j] = w;
        }
    }
}

DI void phase_prep(const Args& a, int layer, unsigned char* smem) {
    int tid_ = threadIdx.x; asm volatile("" : "+v"(tid_)); const int tid = tid_, lane = tid & 63, wid = tid >> 6;
    const int gw = blockIdx.x * 8 + wid, ngw = gridDim.x * 8;
    float* scr = (float*)(smem + wid * 4352);
    unsigned char* ws = a.ws;
    transpose_items(a.in[2] + (size_t)layer * DM * DIN, DM, DIN, (bf16_t*)(ws + WS_WIN), NP, scr, gw, ngw, lane);
    transpose_items(a.in[16] + (size_t)layer * DM * DM, DM, DM, (bf16_t*)(ws + WS_WOUT), DM, scr, gw, ngw, lane);
    transpose_items(a.in[18] + (size_t)layer * DM * DFF, DM, DFF, (bf16_t*)(ws + WS_WUP), DFF, scr, gw, ngw, lane);
    transpose_items(a.in[19] + (size_t)layer * DFF * DM, DFF, DM, (bf16_t*)(ws + WS_WDOWN), DM, scr, gw, ngw, lane);
    transpose_items(a.in[11] + (size_t)layer * 192 * 384, 192, 384, (bf16_t*)(ws + WS_WUQ), 384, scr, gw, ngw, lane);
    transpose_items(a.in[12] + (size_t)layer * 128 * 512, 128, 512, (bf16_t*)(ws + WS_WUKV), 512, scr, gw, ngw, lane);
    if (layer == 0) {
        float* cosT = (float*)(ws + WS_ROPE); float* sinT = cosT + SEQ * 16;
        for (int idx = blockIdx.x * 512 + tid; idx < SEQ * 16; idx += gridDim.x * 512) {
            const int t = idx >> 4, i = idx & 15;
            const float inv = powf(10000.f, -(float)i * (1.f / 16.f));
            const float ang = (float)t * inv;
            const double kq = rint((double)ang * 0.15915494309189535);
            const float rf = (float)((double)ang - kq * 6.283185307179586);
            cosT[idx] = __cosf(rf); sinT[idx] = __sinf(rf);
        }
    }
    const float* x = (layer == 0) ? a.in[0] : a.out;
    rmsnorm_rows(x, a.in[1] + layer * DM, (bf16_t*)(ws + WS_XN), gw, ngw, lane);
}

struct EpiBf16 { bf16_t* O; int ldo;
    DI void operator()(int row, int col, f32x4 v) const { u32x2 w; w[0] = pk2(v[0], v[1]); w[1] = pk2(v[2], v[3]); *(u32x2*)(O + (size_t)row * ldo + col) = w; } };
struct EpiResid { const float* R; float* O;
    DI void operator()(int row, int col, f32x4 v) const { const size_t off = (size_t)row * DM + col; const f32x4 r = *(const f32x4*)(R + off); *(f32x4*)(O + off) = r + v; } };
struct EpiRelu2 { bf16_t* O;
    DI void operator()(int row, int col, f32x4 v) const {
        float t0 = fmaxf(v[0], 0.f), t1 = fmaxf(v[1], 0.f), t2 = fmaxf(v[2], 0.f), t3 = fmaxf(v[3], 0.f);
        u32x2 w; w[0] = pk2(t0 * t0, t1 * t1); w[1] = pk2(t2 * t2, t3 * t3); *(u32x2*)(O + (size_t)row * DFF + col) = w; } };

template <class Epi>
DI void gemm_simple(const bf16_t* __restrict__ A, int lda, const bf16_t* __restrict__ Bt, int ldb, int M, int N, int K, const Epi& E) {
    int tid_ = threadIdx.x; asm volatile("" : "+v"(tid_)); const int tid = tid_, lane = tid & 63, wid = tid >> 6, wr = wid >> 2, wc = wid & 3;
    const int nN = (N + 255) / 256, nunits = (M / 128) * nN;
    const int fr = lane & 15, fq = lane >> 4;
    for (int u = blockIdx.x; u < nunits; u += gridDim.x) {
        const int pm = u / nN, pn = u % nN;
        const int m0 = pm * 128 + wr * 64, n0 = pn * 256 + wc * 64;
        if (n0 >= N) continue;
        f32x4 acc[4][4];
#pragma unroll
        for (int i = 0; i < 4; ++i)
#pragma unroll
            for (int j = 0; j < 4; ++j) acc[i][j] = (f32x4){0.f, 0.f, 0.f, 0.f};
        const bf16_t* ap = A + (size_t)(m0 + fr) * lda + fq * 8;
        const bf16_t* bp = Bt + (size_t)(n0 + fr) * ldb + fq * 8;
#pragma unroll 2
        for (int k = 0; k < K; k += 32) {
            bf16x8 af[4], bfr[4];
#pragma unroll
            for (int i = 0; i < 4; ++i) af[i] = *(const bf16x8*)(ap + (size_t)(i * 16) * lda + k);
#pragma unroll
            for (int j = 0; j < 4; ++j) bfr[j] = *(const bf16x8*)(bp + (size_t)(j * 16) * ldb + k);
#pragma unroll
            for (int i = 0; i < 4; ++i)
#pragma unroll
                for (int j = 0; j < 4; ++j) acc[i][j] = mfma16(bfr[j], af[i], acc[i][j]);
        }
#pragma unroll
        for (int i = 0; i < 4; ++i)
#pragma unroll
            for (int j = 0; j < 4; ++j) E(m0 + i * 16 + fr, n0 + j * 16 + 4 * fq, acc[i][j]);
    }
}

DI void transpose_tile_to_vT(const bf16_t* __restrict__ src, int lds_, int colbase, int colstride_h, bf16_t* __restrict__ dstT, int t0, bf16_t* tile, int tid) {
    _Pragma("unroll 2") for (int e = tid; e < 64 * 32; e += 512) {
        const int r = e >> 5, ch = e & 31, h = ch >> 3, dc = ch & 7;
        const u32x4 v = *(const u32x4*)(src + (size_t)(t0 + r) * lds_ + colbase + h * colstride_h + dc * 8);
        *(u32x4*)(tile + r * 264 + ch * 8) = v;
    }
    __syncthreads();
    const int b = t0 >> 13, t = t0 & 8191;
    _Pragma("unroll 2") for (int e = tid; e < 256 * 8; e += 512) {
        const int hd = e >> 3, ch = e & 7;
        unsigned w[4];
#pragma unroll
        for (int j = 0; j < 4; ++j) w[j] = (unsigned)tile[(ch * 8 + 2 * j) * 264 + hd] | ((unsigned)tile[(ch * 8 + 2 * j + 1) * 264 + hd] << 16);
        u32x4 v; v[0] = w[0]; v[1] = w[1]; v[2] = w[2]; v[3] = w[3];
        *(u32x4*)(dstT + ((size_t)(b * 256 + hd)) * SEQ + t + ch * 8) = v;
    }
    __syncthreads();
}

DI void phase_post1(const Args& a, int layer, unsigned char* smem) {
    int tid_ = threadIdx.x; asm volatile("" : "+v"(tid_)); const int tid = tid_, lane = tid & 63, wid = tid >> 6;
    bf16_t* proj = (bf16_t*)(a.ws + WS_PROJ);
    const float* gq = a.in[6] + layer * 64; const float* gk = a.in[7] + layer * 64;
    const float* gcq = a.in[9] + layer * 192; const float* gckv = a.in[10] + layer * 128;
    for (int u = blockIdx.x; u < MTOK / 64; u += gridDim.x) {
        const int t0 = u * 64;
        for (int i = 0; i < 8; ++i) {
            bf16_t* p = proj + (size_t)(t0 + wid * 8 + i) * NP;
#pragma unroll
            for (int h = 0; h < 4; ++h) {
                float v = bf2f(p[C_DQ + h * 64 + lane]); float ss = wave_sum(v * v); float rinv = rsqrtf(ss * (1.f / 64.f) + RMS_EPS);
                p[C_DQ + h * 64 + lane] = f2bf(v * rinv * gq[lane] * DSA_QS);
                v = bf2f(p[C_DK + h * 64 + lane]); ss = wave_sum(v * v); rinv = rsqrtf(ss * (1.f / 64.f) + RMS_EPS);
                p[C_DK + h * 64 + lane] = f2bf(v * rinv * gk[lane]);
            }
            {
                const float c0 = bf2f(p[C_MCQ + lane]), c1 = bf2f(p[C_MCQ + 64 + lane]), c2 = bf2f(p[C_MCQ + 128 + lane]);
                const float ss = wave_sum(c0 * c0 + c1 * c1 + c2 * c2); const float rinv = rsqrtf(ss * (1.f / 192.f) + RMS_EPS);
                p[C_MCQ + lane] = f2bf(c0 * rinv * gcq[lane]); p[C_MCQ + 64 + lane] = f2bf(c1 * rinv * gcq[64 + lane]); p[C_MCQ + 128 + lane] = f2bf(c2 * rinv * gcq[128 + lane]);
            }
            {
                const float c0 = bf2f(p[C_MCKV + lane]), c1 = bf2f(p[C_MCKV + 64 + lane]);
                const float ss = wave_sum(c0 * c0 + c1 * c1); const float rinv = rsqrtf(ss * (1.f / 128.f) + RMS_EPS);
                p[C_MCKV + lane] = f2bf(c0 * rinv * gckv[lane]); p[C_MCKV + 64 + lane] = f2bf(c1 * rinv * gckv[64 + lane]);
            }
        }
        transpose_tile_to_vT(proj, NP, C_DV, 64, (bf16_t*)(a.ws + WS_VDT), t0, (bf16_t*)smem, tid);
    }
}

DI void phase_post2(const Args& a, int layer, unsigned char* smem) {
    int tid_ = threadIdx.x; asm volatile("" : "+v"(tid_)); const int tid = tid_, lane = tid & 63, wid = tid >> 6;
    const bf16_t* proj = (const bf16_t*)(a.ws + WS_PROJ);
    bf16_t* qm = (bf16_t*)(a.ws + WS_QM); bf16_t* km = (bf16_t*)(a.ws + WS_KM);
    const bf16_t* kvraw = (const bf16_t*)(a.ws + WS_MASK);
    const float* gqn = a.in[13] + layer * 96; const float* gkn = a.in[14] + layer * 96;
    const float* cosT = (const float*)(a.ws + WS_ROPE); const float* sinT = cosT + SEQ * 16;
    for (int u = blockIdx.x; u < MTOK / 64; u += gridDim.x) {
        const int t0 = u * 64;
        for (int i = 0; i < 8; ++i) {
            const int row = t0 + wid * 8 + i, t = row & 8191;
            const float cs = cosT[t * 16 + (lane & 15)], sn = sinT[t * 16 + (lane & 15)];
#pragma unroll
            for (int h = 0; h < 4; ++h) {
                {
                    bf16_t* q = qm + (size_t)row * 384 + h * 96;
                    float v0 = bf2f(q[lane]); float v1 = (lane < 32) ? bf2f(q[64 + lane]) : 0.f;
                    const float ss = wave_sum(v0 * v0 + v1 * v1); const float rinv = rsqrtf(ss * (1.f / 96.f) + RMS_EPS);
                    v0 = v0 * rinv * gqn[lane]; v1 = (lane < 32) ? v1 * rinv * gqn[64 + lane] : 0.f;
                    const float pr = __shfl_xor(v1, 16);
                    const float r1 = (lane < 16) ? (v1 * cs - pr * sn) : (v1 * cs + pr * sn);
                    q[lane] = f2bf(v0 * MLA_QS); if (lane < 32) q[64 + lane] = f2bf(r1 * MLA_QS);
                }
                {
                    float v0 = bf2f(kvraw[(size_t)row * 512 + h * 128 + lane]); float v1 = (lane < 32) ? bf2f(proj[(size_t)row * NP + C_MKR + lane]) : 0.f;
                    const float ss = wave_sum(v0 * v0 + v1 * v1); const float rinv = rsqrtf(ss * (1.f / 96.f) + RMS_EPS);
                    v0 = v0 * rinv * gkn[lane]; v1 = (lane < 32) ? v1 * rinv * gkn[64 + lane] : 0.f;
                    const float pr = __shfl_xor(v1, 16);
                    const float r1 = (lane < 16) ? (v1 * cs - pr * sn) : (v1 * cs + pr * sn);
                    bf16_t* k = km + (size_t)row * 384 + h * 96;
                    k[lane] = f2bf(v0); if (lane < 32) k[64 + lane] = f2bf(r1);
                }
            }
        }
        transpose_tile_to_vT(kvraw, 512, 64, 128, (bf16_t*)(a.ws + WS_VMT), t0, (bf16_t*)smem, tid);
    }
}

constexpr int GL_B = 0, GL_GLR = 16384, GL_GU = 20480, GL_BIAS = 24576, GL_QDEC = 24832, GL_KINV = 34048, GL_VT = 43264, GL_SPT = 61696, GL_SC = 80128, GL_O = 89344;
DI float logsig(float z) { return fminf(z, 0.f) - log1pf(expf(-fabsf(z))); }

DI void gla_stage_b(const Args& a, int layer, unsigned char* smem, int h, size_t row0) {
    int tid_ = threadIdx.x; asm volatile("" : "+v"(tid_)); const int tid = tid_;
    const bf16_t* proj = (const bf16_t*)(a.ws + WS_PROJ);
    float* bL = (float*)(smem + GL_B); float* glr = (float*)(smem + GL_GLR); float* gu = (float*)(smem + GL_GU); float* bias = (float*)(smem + GL_BIAS);
    const float* gup = a.in[3] + (size_t)layer * 16 * 256; const float* gb = a.in[4] + layer * 256;
    _Pragma("unroll 2") for (int e = tid; e < 1024; e += 512) { const int c = e >> 4, r = e & 15; glr[e] = bf2f(proj[(row0 + c) * NP + C_GLR + r]); }
    _Pragma("unroll 2") for (int e = tid; e < 1024; e += 512) { const int r = e >> 6, d = e & 63; gu[e] = gup[r * 256 + h * 64 + d]; }
    if (tid < 64) bias[tid] = gb[h * 64 + tid];
    __syncthreads();
    _Pragma("unroll 2") for (int e = tid; e < 4096; e += 512) {
        const int c = e >> 6, d = e & 63; float z = bias[d];
#pragma unroll
        for (int r = 0; r < 16; ++r) z = fmaf(glr[c * 16 + r], gu[r * 64 + d], z);
        bL[e] = logsig(z) * (1.f / 16.f);
    }
    __syncthreads();
    if (tid < 64) { float run = 0.f; for (int c = 0; c < 64; ++c) { run += bL[c * 64 + tid]; bL[c * 64 + tid] = run; } }
    __syncthreads();
}

DI void phase_gla1(const Args& a, int layer, unsigned char* smem) {
    int tid_ = threadIdx.x; asm volatile("" : "+v"(tid_)); const int tid = tid_, lane = tid & 63, wid = tid >> 6;
    const bf16_t* proj = (const bf16_t*)(a.ws + WS_PROJ);
    float* G = (float*)(a.ws + WS_GLA); float* dec = (float*)(a.ws + WS_GDEC);
    float* bL = (float*)(smem + GL_B); bf16_t* kendT = (bf16_t*)(smem + GL_KINV); bf16_t* VT = (bf16_t*)(smem + GL_VT);
    for (int u = blockIdx.x; u < 1024; u += gridDim.x) {
        const int bh = u >> 7, n = u & 127, b = bh >> 2, h = bh & 3;
        const size_t row0 = (size_t)b * SEQ + n * 64;
        gla_stage_b(a, layer, smem, h, row0);
        _Pragma("unroll 2") for (int e = tid; e < 4096; e += 512) {
            const int c = e >> 6, d = e & 63;
            const float k = bf2f(proj[(row0 + c) * NP + C_GK + h * 64 + d]);
            kendT[d * 72 + c] = f2bf(k * expf(bL[63 * 64 + d] - bL[c * 64 + d]));
        }
        _Pragma("unroll 2") for (int e = tid; e < 8192; e += 512) { const int c = e >> 7, v = e & 127; VT[v * 72 + c] = proj[(row0 + c) * NP + C_GV + h * 128 + v]; }
        if (tid < 64) dec[(size_t)u * 64 + tid] = expf(bL[63 * 64 + tid]);
        __syncthreads();
#pragma unroll
        for (int i = 0; i < 4; ++i) {
            const int tile = wid * 4 + i, tv = tile >> 2, td = tile & 3;
            f32x4 acc = {0.f, 0.f, 0.f, 0.f};
#pragma unroll
            for (int ks = 0; ks < 2; ++ks) {
                const bf16x8 av = *(const bf16x8*)(VT + (tv * 16 + (lane & 15)) * 72 + ks * 32 + 8 * (lane >> 4));
                const bf16x8 bv = *(const bf16x8*)(kendT + (td * 16 + (lane & 15)) * 72 + ks * 32 + 8 * (lane >> 4));
                acc = mfma16(av, bv, acc);
            }
#pragma unroll
            for (int r = 0; r < 4; ++r) G[((size_t)u * 128 + tv * 16 + 4 * (lane >> 4) + r) * 64 + td * 16 + (lane & 15)] = acc[r];
        }
        __syncthreads();
    }
}

DI void phase_gla2(const Args& a) {
    float* G = (float*)(a.ws + WS_GLA); const float* dec = (const float*)(a.ws + WS_GDEC);
    for (int e = blockIdx.x * 512 + threadIdx.x; e < 65536; e += gridDim.x * 512) {
        const int bh = e >> 13, vd = e & 8191, d = e & 63;
        float st = 0.f;
        for (int n0 = 0; n0 < 128; n0 += 8) {
            float inc[8], dc[8];
#pragma unroll
            for (int j = 0; j < 8; ++j) { const size_t un = (size_t)bh * 128 + n0 + j; inc[j] = G[un * 8192 + vd]; dc[j] = dec[un * 64 + d]; }
#pragma unroll
            for (int j = 0; j < 8; ++j) { const size_t un = (size_t)bh * 128 + n0 + j; G[un * 8192 + vd] = st; st = fmaf(dc[j], st, inc[j]); }
        }
    }
}

DI void phase_gla3(const Args& a, int layer, unsigned char* smem) {
    int tid_ = threadIdx.x; asm volatile("" : "+v"(tid_)); const int tid = tid_, lane = tid & 63, wid = tid >> 6;
    const bf16_t* proj = (const bf16_t*)(a.ws + WS_PROJ);
    const float* G = (const float*)(a.ws + WS_GLA);
    bf16_t* mix = (bf16_t*)(a.ws + WS_XN);
    const float* gnorm = a.in[5] + layer * 512;
    float* bL = (float*)(smem + GL_B); bf16_t* qdec = (bf16_t*)(smem + GL_QDEC); bf16_t* kinv = (bf16_t*)(smem + GL_KINV); bf16_t* VT = (bf16_t*)(smem + GL_VT);
    bf16_t* SpT = (bf16_t*)(smem + GL_SPT); bf16_t* sc = (bf16_t*)(smem + GL_SC); float* oL = (float*)(smem + GL_O);
    for (int u = blockIdx.x; u < 1024; u += gridDim.x) {
        const int bh = u >> 7, n = u & 127, b = bh >> 2, h = bh & 3;
        const size_t row0 = (size_t)b * SEQ + n * 64;
        gla_stage_b(a, layer, smem, h, row0);
        _Pragma("unroll 2") for (int e = tid; e < 4096; e += 512) {
            const int c = e >> 6, d = e & 63; const float bb = bL[e];
            const float q = bf2f(proj[(row0 + c) * NP + C_GQ + h * 64 + d]), k = bf2f(proj[(row0 + c) * NP + C_GK + h * 64 + d]);
            qdec[c * 72 + d] = f2bf(q * 0.125f * expf(bb)); kinv[c * 72 + d] = f2bf(k * expf(-bb));
        }
        _Pragma("unroll 2") for (int e = tid; e < 8192; e += 512) { const int c = e >> 7, v = e & 127; VT[v * 72 + c] = proj[(row0 + c) * NP + C_GV + h * 128 + v]; }
        _Pragma("unroll 2") for (int e = tid; e < 8192; e += 512) { const int v = e >> 6, d = e & 63; SpT[v * 72 + d] = f2bf(G[(size_t)u * 8192 + e]); }
        _Pragma("unroll 2") for (int e = tid; e < 64 * 72 / 2; e += 512) ((unsigned*)sc)[e] = 0u;
        __syncthreads();
        for (int idx = wid; idx < 10; idx += 8) {
            int tc = 0, rem = idx; while (rem > tc) { rem -= tc + 1; ++tc; } const int ts = rem;
            f32x4 acc = {0.f, 0.f, 0.f, 0.f};
#pragma unroll
            for (int ks = 0; ks < 2; ++ks) {
                const bf16x8 av = *(const bf16x8*)(qdec + (tc * 16 + (lane & 15)) * 72 + ks * 32 + 8 * (lane >> 4));
                const bf16x8 bv = *(const bf16x8*)(kinv + (ts * 16 + (lane & 15)) * 72 + ks * 32 + 8 * (lane >> 4));
                acc = mfma16(av, bv, acc);
            }
            const int s = ts * 16 + (lane & 15);
#pragma unroll
            for (int r = 0; r < 4; ++r) { const int c = tc * 16 + 4 * (lane >> 4) + r; sc[c * 72 + s] = f2bf((s <= c) ? acc[r] : 0.f); }
        }
        __syncthreads();
#pragma unroll
        for (int i = 0; i < 4; ++i) {
            const int tile = wid * 4 + i, tc = tile >> 3, tv = tile & 7;
            f32x4 acc = {0.f, 0.f, 0.f, 0.f};
#pragma unroll
            for (int ks = 0; ks < 2; ++ks) {
                const bf16x8 av = *(const bf16x8*)(sc + (tc * 16 + (lane & 15)) * 72 + ks * 32 + 8 * (lane >> 4));
                const bf16x8 bv = *(const bf16x8*)(VT + (tv * 16 + (lane & 15)) * 72 + ks * 32 + 8 * (lane >> 4));
                acc = mfma16(av, bv, acc);
            }
#pragma unroll
            for (int ks = 0; ks < 2; ++ks) {
                const bf16x8 av = *(const bf16x8*)(qdec + (tc * 16 + (lane & 15)) * 72 + ks * 32 + 8 * (lane >> 4));
                const bf16x8 bv = *(const bf16x8*)(SpT + (tv * 16 + (lane & 15)) * 72 + ks * 32 + 8 * (lane >> 4));
                acc = mfma16(av, bv, acc);
            }
#pragma unroll
            for (int r = 0; r < 4; ++r) oL[(tc * 16 + 4 * (lane >> 4) + r) * 132 + tv * 16 + (lane & 15)] = acc[r];
        }
        __syncthreads();
        {
            const int c = tid >> 3, sub = tid & 7;
            float ov[16]; float ss = 0.f;
#pragma unroll
            for (int j = 0; j < 16; ++j) { ov[j] = oL[c * 132 + sub * 16 + j]; ss += ov[j] * ov[j]; }
            ss += __shfl_xor(ss, 1); ss += __shfl_xor(ss, 2); ss += __shfl_xor(ss, 4);
            const float rinv = rsqrtf(ss * (1.f / 128.f) + RMS_EPS);
            const bf16_t* gp = proj + (row0 + c) * NP + C_GG + h * 128 + sub * 16;
            bf16_t* mp = mix + (row0 + c) * DM + h * 128 + sub * 16;
            unsigned w[8];
#pragma unroll
            for (int j = 0; j < 16; j += 2) {
                const float g0 = bf2f(gp[j]), g1 = bf2f(gp[j + 1]);
                const float s0 = g0 / (1.f + expf(-g0)), s1 = g1 / (1.f + expf(-g1));
                w[j >> 1] = pk2(ov[j] * rinv * gnorm[h * 128 + sub * 16 + j] * s0, ov[j + 1] * rinv * gnorm[h * 128 + sub * 16 + j + 1] * s1);
            }
            u32x4 w0, w1; w0[0] = w[0]; w0[1] = w[1]; w0[2] = w[2]; w0[3] = w[3]; w1[0] = w[4]; w1[1] = w[5]; w1[2] = w[6]; w1[3] = w[7];
            *(u32x4*)mp = w0; *(u32x4*)(mp + 8) = w1;
        }
        __syncthreads();
    }
}

DI unsigned fkey(float s) { const unsigned u = __float_as_uint(s); return (u & 0x80000000u) ? ~u : (u | 0x80000000u); }
DI void dsa_scores(bf16x8 ka, const bf16x8 (&bq)[8], const float (&w)[8], float (&sc)[4]) {
    const f32x4 z = {0.f, 0.f, 0.f, 0.f};
    sc[0] = 0.f; sc[1] = 0.f; sc[2] = 0.f; sc[3] = 0.f;
#pragma unroll
    for (int h = 0; h < 8; ++h) {
        const f32x4 d = mfma16(ka, bq[h], z);
#pragma unroll
        for (int r = 0; r < 4; ++r) sc[r] = __builtin_fmaf(w[h], fmaxf(d[r], 0.f), sc[r]);
    }
#pragma unroll
    for (int r = 0; r < 4; ++r) sc[r] += 0.0f;
}

DI void phase_dsa_select(const Args& a, unsigned char* smem) {
    int tid_ = threadIdx.x; asm volatile("" : "+v"(tid_)); const int tid = tid_, lane = tid & 63, wid = tid >> 6;
    const bf16_t* proj = (const bf16_t*)(a.ws + WS_PROJ);
    unsigned* mask = (unsigned*)(a.ws + WS_MASK);
    unsigned* hist = (unsigned*)smem;
    unsigned* maskL = (unsigned*)smem; unsigned long long* cand = (unsigned long long*)(smem + 16384);
    int* sel = (int*)(smem + 131072); int* cnt = sel + 64;
    const int qrow = lane & 15, kq = lane >> 4;
    for (int u = blockIdx.x; u < 1024; u += gridDim.x) {
        const int b = u & 1, t0 = (511 - (u >> 1)) * 16;
        const size_t g0 = (size_t)b * SEQ + t0;
        unsigned* gmask = mask + g0 * 256;
        if (t0 < 256) {
            _Pragma("unroll 2") for (int e = tid; e < 4096; e += 512) {
                const int r = e >> 8, j = e & 255, t = t0 + r; unsigned w;
                if (32 * j + 31 <= t) w = 0xFFFFFFFFu; else if (32 * j > t) w = 0u; else w = (2u << (t - 32 * j)) - 1u;
                gmask[e] = w;
            }
            continue;
        }
        const bf16_t* qp = proj + (g0 + qrow) * NP;
        bf16x8 bq[8]; float w[8];
#pragma unroll
        for (int h = 0; h < 8; ++h) { bq[h] = *(const bf16x8*)(qp + C_IQ + h * 32 + kq * 8); w[h] = bf2f(qp[C_IW + h]) * 0.0625f; }
        const int tq = t0 + qrow, nkt = t0 / 16 + 1;
        const bf16_t* kbase = proj + ((size_t)b * SEQ + qrow) * NP + C_IK + kq * 8;
        _Pragma("unroll 2") for (int e = tid; e < 16 * 2048; e += 512) hist[e] = 0u;
        __syncthreads();
        for (int kt = wid; kt < nkt; kt += 8) {
            const bf16x8 ka = *(const bf16x8*)(kbase + (size_t)(kt * 16) * NP);
            float sc[4]; dsa_scores(ka, bq, w, sc);
#pragma unroll
            for (int r = 0; r < 4; ++r) {
                const int kp = kt * 16 + kq * 4 + r;
                if (kp <= tq) { const unsigned bin = fkey(sc[r]) >> 20; atomicAdd(&hist[qrow * 2048 + (bin >> 1)], 1u << ((bin & 1) * 16)); }
            }
        }
        __syncthreads();
        for (int rr = 0; rr < 2; ++rr) {
            const int row = wid * 2 + rr; const unsigned* hrow = hist + row * 2048;
            unsigned c = 0;
            for (int i = 0; i < 32; ++i) { const unsigned wv = hrow[lane * 32 + i]; c += (wv & 0xFFFFu) + (wv >> 16); }
            unsigned incl = c;
#pragma unroll
            for (int off = 1; off < 64; off <<= 1) { const unsigned o = __shfl_down(incl, off); if (lane + off < 64) incl += o; }
            const unsigned above = incl - c;
            if (above < 256u && incl >= 256u) {
                unsigned run = above; int bst = lane * 64; unsigned ca = above;
                for (int bin = lane * 64 + 63; bin >= lane * 64; --bin) {
                    const unsigned wv = hrow[bin >> 1]; const unsigned cn = (bin & 1) ? (wv >> 16) : (wv & 0xFFFFu);
                    if (run + cn >= 256u) { bst = bin; ca = run; break; }
                    run += cn;
                }
                sel[row * 2] = bst; sel[row * 2 + 1] = (int)ca;
            }
        }
        __syncthreads();
        const int bst_l = sel[qrow * 2];
        __syncthreads();
        _Pragma("unroll 2") for (int e = tid; e < 4096; e += 512) maskL[e] = 0u;
        if (tid < 16) cnt[tid] = 0;
        __syncthreads();
        for (int kt = wid; kt < nkt; kt += 8) {
            const bf16x8 ka = *(const bf16x8*)(kbase + (size_t)(kt * 16) * NP);
            float sc[4]; dsa_scores(ka, bq, w, sc);
            unsigned bits = 0u;
#pragma unroll
            for (int r = 0; r < 4; ++r) {
                const int kp = kt * 16 + kq * 4 + r;
                if (kp <= tq) {
                    const unsigned key = fkey(sc[r]); const int bin = (int)(key >> 20);
                    if (bin > bst_l) bits |= 1u << r;
                    else if (bin == bst_l) { const int pos = atomicAdd(&cnt[qrow], 1); if (pos < CAND_CAP) cand[qrow * CAND_CAP + pos] = ((unsigned long long)key << 32) | (unsigned long long)(0xFFFFFFFFu - (unsigned)kp); }
                }
            }
            if (bits) atomicOr(&maskL[qrow * 256 + (kt >> 1)], bits << ((kt & 1) * 16 + kq * 4));
        }
        __syncthreads();
        for (int rr = 0; rr < 2; ++rr) {
            const int row = wid * 2 + rr; const int n = min(cnt[row], CAND_CAP); const int need = 256 - sel[row * 2 + 1];
            for (int i = lane; i < n; i += 64) {
                const unsigned long long ci = cand[row * CAND_CAP + i]; int rank = 0;
                for (int m = 0; m < n; ++m) rank += (cand[row * CAND_CAP + m] > ci) ? 1 : 0;
                if (rank < need) { const unsigned kp = 0xFFFFFFFFu - (unsigned)(ci & 0xFFFFFFFFull); atomicOr(&maskL[row * 256 + (kp >> 5)], 1u << (kp & 31)); }
            }
        }
        __syncthreads();
        _Pragma("unroll 2") for (int e = tid; e < 4096; e += 512) gmask[e] = maskL[e];
        __syncthreads();
    }
}

template <int DQ, bool USE_MASK>
DI void attn_wave(const bf16_t* __restrict__ Q, int ldq, int qcol, const bf16_t* __restrict__ K, int ldk, int kcol, const bf16_t* __restrict__ VTb,
                  const unsigned* __restrict__ mask, int b, int qb, int lane, bf16_t* __restrict__ mix, int mixcol, const float* __restrict__ gain) {
    const int r32 = lane & 31, hi = lane >> 5;
    const size_t rb = (size_t)b * SEQ; const int q0 = qb * 32;
    constexpr int NS = DQ / 16;
    bf16x8 qf[NS];
#pragma unroll
    for (int s = 0; s < NS; ++s) qf[s] = *(const bf16x8*)(Q + (rb + q0 + r32) * ldq + qcol + 16 * s + 8 * hi);
    f32x16 o0, o1;
#pragma unroll
    for (int r = 0; r < 16; ++r) { o0[r] = 0.f; o1[r] = 0.f; }
    float m = -1e30f, l = 0.f;
    const unsigned* mrow = mask + (rb + q0 + r32) * 256;
    for (int kt = 0; kt <= qb; ++kt) {
        f32x16 p;
#pragma unroll
        for (int r = 0; r < 16; ++r) p[r] = 0.f;
        const bf16_t* kp = K + (rb + kt * 32 + r32) * ldk + kcol + 8 * hi;
#pragma unroll
        for (int s = 0; s < NS; ++s) { const bf16x8 kf = *(const bf16x8*)(kp + 16 * s); p = mfma32(kf, qf[s], p); }
        unsigned vbits;
        if (USE_MASK) vbits = mrow[kt];
        else vbits = (kt < qb) ? 0xFFFFFFFFu : ((2u << r32) - 1u);
        float pm = -1e30f;
#pragma unroll
        for (int r = 0; r < 16; ++r) { const bool v = (vbits >> crow(r, hi)) & 1u; pm = fmaxf(pm, v ? p[r] : -1e30f); }
        pm = fmaxf(pm, __shfl_xor(pm, 32));
        const float mn = fmaxf(m, pm); const float alpha = __builtin_amdgcn_exp2f(m - mn); m = mn;
        float ls = 0.f;
#pragma unroll
        for (int r = 0; r < 16; ++r) { const bool v = (vbits >> crow(r, hi)) & 1u; const float e = v ? __builtin_amdgcn_exp2f(p[r] - mn) : 0.f; p[r] = e; ls += e; }
        l = l * alpha + ls;
#pragma unroll
        for (int r = 0; r < 16; ++r) { o0[r] *= alpha; o1[r] *= alpha; }
        bf16x8 pk[2];
#pragma unroll
        for (int s = 0; s < 2; ++s) {
            u32x4 w; w[0] = pk2(p[8 * s], p[8 * s + 1]); w[1] = pk2(p[8 * s + 2], p[8 * s + 3]); w[2] = pk2(p[8 * s + 4], p[8 * s + 5]); w[3] = pk2(p[8 * s + 6], p[8 * s + 7]);
            pk[s] = __builtin_bit_cast(bf16x8, w);
        }
#pragma unroll
        for (int s = 0; s < 2; ++s) {
            const bf16_t* v0p = VTb + (size_t)r32 * SEQ + kt * 32 + 16 * s + 4 * hi;
            const bf16_t* v1p = v0p + (size_t)32 * SEQ;
            const u32x2 a0 = *(const u32x2*)v0p, a1 = *(const u32x2*)(v0p + 8);
            const u32x2 c0 = *(const u32x2*)v1p, c1 = *(const u32x2*)(v1p + 8);
            u32x4 f0, f1; f0[0] = a0[0]; f0[1] = a0[1]; f0[2] = a1[0]; f0[3] = a1[1]; f1[0] = c0[0]; f1[1] = c0[1]; f1[2] = c1[0]; f1[3] = c1[1];
            o0 = mfma32(__builtin_bit_cast(bf16x8, f0), pk[s], o0);
            o1 = mfma32(__builtin_bit_cast(bf16x8, f1), pk[s], o1);
        }
    }
    l += __shfl_xor(l, 32);
    const float linv = 1.f / l;
    float ss = 0.f;
#pragma unroll
    for (int r = 0; r < 16; ++r) { o0[r] *= linv; o1[r] *= linv; ss += o0[r] * o0[r] + o1[r] * o1[r]; }
    ss += __shfl_xor(ss, 32);
    const float rinv = rsqrtf(ss * (1.f / 64.f) + RMS_EPS);
    bf16_t* mp = mix + (rb + q0 + r32) * DM + mixcol;
#pragma unroll
    for (int g = 0; g < 4; ++g) {
        const int d0 = 8 * g + 4 * hi;
        u32x2 w;
        w[0] = pk2(o0[4 * g] * rinv * gain[d0], o0[4 * g + 1] * rinv * gain[d0 + 1]); w[1] = pk2(o0[4 * g + 2] * rinv * gain[d0 + 2], o0[4 * g + 3] * rinv * gain[d0 + 3]);
        *(u32x2*)(mp + d0) = w;
        w[0] = pk2(o1[4 * g] * rinv * gain[32 + d0], o1[4 * g + 1] * rinv * gain[32 + d0 + 1]); w[1] = pk2(o1[4 * g + 2] * rinv * gain[32 + d0 + 2], o1[4 * g + 3] * rinv * gain[32 + d0 + 3]);
        *(u32x2*)(mp + 32 + d0) = w;
    }
}

DI void phase_attn_mla(const Args& a, int layer) {
    const int lane = threadIdx.x & 63, wid = threadIdx.x >> 6;
    const bf16_t* qm = (const bf16_t*)(a.ws + WS_QM); const bf16_t* km = (const bf16_t*)(a.ws + WS_KM); const bf16_t* vmT = (const bf16_t*)(a.ws + WS_VMT);
    bf16_t* mix = (bf16_t*)(a.ws + WS_XN);
    for (int u = blockIdx.x * 8 + wid; u < 2048; u += gridDim.x * 8) {
        const int kk = u >> 3, w = u & 7, b = w >> 2, h = w & 3, qb = 255 - ((kk + 32 * w) & 255);
        attn_wave<96, false>(qm, 384, h * 96, km, 384, h * 96, vmT + (size_t)(w * 64) * SEQ, (const unsigned*)(a.ws + WS_MASK), b, qb, lane, mix, 768 + h * 64, a.in[15] + layer * 256 + h * 64);
    }
}
DI void phase_attn_dsa(const Args& a, int layer) {
    const int lane = threadIdx.x & 63, wid = threadIdx.x >> 6;
    const bf16_t* proj = (const bf16_t*)(a.ws + WS_PROJ); const bf16_t* vdT = (const bf16_t*)(a.ws + WS_VDT);
    bf16_t* mix = (bf16_t*)(a.ws + WS_XN);
    for (int u = blockIdx.x * 8 + wid; u < 2048; u += gridDim.x * 8) {
        const int kk = u >> 3, w = u & 7, b = w >> 2, h = w & 3, qb = 255 - ((kk + 32 * w) & 255);
        attn_wave<64, true>(proj, NP, C_DQ + h * 64, proj, NP, C_DK + h * 64, vdT + (size_t)(w * 64) * SEQ, (const unsigned*)(a.ws + WS_MASK), b, qb, lane, mix, 512 + h * 64, a.in[8] + layer * 256 + h * 64);
    }
}

__global__ void __launch_bounds__(512, 2) fwd_kernel(Args a) {
    extern __shared__ __attribute__((aligned(16))) unsigned char smem[];
    cg::grid_group grid = cg::this_grid();
    unsigned char* ws = a.ws;
    const int lane = threadIdx.x & 63, wid = threadIdx.x >> 6;
    for (int ph = a.ph_lo; ph < a.ph_hi; ++ph) {
        const int layer = ph / NPH, p = ph % NPH;
        asm volatile("" : "+s"(ws));
        switch (p) {
        case 0: phase_prep(a, layer, smem); break;
        case 1: { EpiBf16 E{(bf16_t*)(ws + WS_PROJ), NP}; gemm_simple((const bf16_t*)(ws + WS_XN), DM, (const bf16_t*)(ws + WS_WIN), DM, MTOK, NP, DM, E); } break;
        case 2: phase_post1(a, layer, smem); break;
        case 3: {
            EpiBf16 E1{(bf16_t*)(ws + WS_QM), 384}; gemm_simple((const bf16_t*)(ws + WS_PROJ) + C_MCQ, NP, (const bf16_t*)(ws + WS_WUQ), 192, MTOK, 384, 192, E1);
            EpiBf16 E2{(bf16_t*)(ws + WS_MASK), 512}; gemm_simple((const bf16_t*)(ws + WS_PROJ) + C_MCKV, NP, (const bf16_t*)(ws + WS_WUKV), 128, MTOK, 512, 128, E2);
        } break;
        case 4: phase_post2(a, layer, smem); break;
        case 5: phase_gla1(a, layer, smem); phase_dsa_select(a, smem); phase_attn_mla(a, layer); break;
        case 6: phase_gla2(a); phase_attn_dsa(a, layer); break;
        case 7: phase_gla3(a, layer, smem); break;
        case 8: { EpiResid E{layer == 0 ? a.in[0] : a.out, a.out}; gemm_simple((const bf16_t*)(ws + WS_XN), DM, (const bf16_t*)(ws + WS_WOUT), DM, MTOK, DM, DM, E); } break;
        case 9: rmsnorm_rows(a.out, a.in[17] + layer * DM, (bf16_t*)(ws + WS_XN), blockIdx.x * 8 + wid, gridDim.x * 8, lane); break;
        case 10: { EpiRelu2 E{(bf16_t*)(ws + WS_U)}; gemm_simple((const bf16_t*)(ws + WS_XN), DM, (const bf16_t*)(ws + WS_WUP), DM, MTOK, DFF, DM, E); } break;
        case 11: { EpiResid E{a.out, a.out}; gemm_simple((const bf16_t*)(ws + WS_U), DFF, (const bf16_t*)(ws + WS_WDOWN), DFF, MTOK, DM, DFF, E); } break;
        }
        if (ph + 1 < a.ph_hi) grid.sync();
    }
}

extern "C" void kernel_launch(void* const* d_in, const int* in_sizes, int n_in, void* d_out, int out_size, void* d_ws, size_t ws_size, hipStream_t stream) {
    static int grid_blocks = 0;
    if (grid_blocks == 0) {
        if (n_in != 20 || ws_size < WS_END) { fprintf(stderr, "kernel_launch: unexpected n_in %d / ws_size %zu\n", n_in, ws_size); grid_blocks = -1; return; }
        int dev = 0, cus = 0, per_cu = 0;
        hipGetDevice(&dev);
        hipDeviceGetAttribute(&cus, hipDeviceAttributeMultiprocessorCount, dev);
        hipFuncSetAttribute((const void*)fwd_kernel, hipFuncAttributeMaxDynamicSharedMemorySize, LDS_BYTES);
        hipOccupancyMaxActiveBlocksPerMultiprocessor(&per_cu, (const void*)fwd_kernel, 512, LDS_BYTES);
        if (per_cu < 1) { fprintf(stderr, "kernel_launch: occupancy query says %d blocks/CU\n", per_cu); per_cu = 1; }
        if (per_cu > 1) per_cu = 1;
        grid_blocks = cus * per_cu;
        (void)hipGetLastError();
    }
    if (grid_blocks < 0) return;
    Args a{};
    for (int i = 0; i < 20; ++i) a.in[i] = (const float*)d_in[i];
    a.out = (float*)d_out; a.ws = (unsigned char*)d_ws;
#if N_LAUNCH_MODE == 1
    a.ph_lo = 0; a.ph_hi = 2 * NPH;
    void* args[] = {&a};
    hipError_t e = hipLaunchCooperativeKernel((const void*)fwd_kernel, dim3(grid_blocks), dim3(512), args, LDS_BYTES, stream);
    if (e != hipSuccess) fprintf(stderr, "cooperative launch failed: %s (grid %d)\n", hipGetErrorString(e), grid_blocks);
#else
    for (int ph = 0; ph < 2 * NPH; ++ph) {
        a.ph_lo = ph; a.ph_hi = ph + 1;
        hipLaunchKernelGGL(fwd_kernel, dim3(grid_blocks), dim3(512), LDS_BYTES, stream, a);
    }
#endif
}
```

```cpp
#include <hip/hip_runtime.h>
#include <hip/hip_cooperative_groups.h>
#include <cstdio>
#include <cstdint>
namespace cg = cooperative_groups;

#ifndef N_LAUNCH_MODE
#define N_LAUNCH_MODE 1
#endif

#define DI __device__ __forceinline__
typedef unsigned short bf16_t;
typedef short bf16x8 __attribute__((ext_vector_type(8)));
typedef short bf16x4 __attribute__((ext_vector_type(4)));
typedef float f32x4 __attribute__((ext_vector_type(4)));
typedef float f32x16 __attribute__((ext_vector_type(16)));
typedef unsigned u32x4 __attribute__((ext_vector_type(4)));
typedef unsigned u32x2 __attribute__((ext_vector_type(2)));

constexpr int SEQ = 8192, MTOK = 16384, DM = 1024, NP = 3072, DIN = 2968, DFF = 4096;
constexpr int C_GQ = 0, C_GK = 256, C_GV = 512, C_GG = 1024, C_GLR = 1536, C_DQ = 1552, C_DK = 1808, C_DV = 2064,
              C_IQ = 2320, C_IK = 2576, C_IW = 2608, C_MCQ = 2616, C_MCKV = 2808, C_MKR = 2936;
constexpr float RMS_EPS = 1e-6f;
constexpr float LOG2E = 1.4426950408889634f;
constexpr float DSA_QS = 0.125f * LOG2E;
constexpr float MLA_QS = 0.10206207261596577f * LOG2E;
constexpr int NPH = 12;
constexpr int LDS_BYTES = 147456;
constexpr int CAND_CAP = 768;

constexpr size_t MiB = 1u << 20;
constexpr size_t WS_WIN = 1 * MiB, WS_WOUT = 7 * MiB, WS_WUP = 9 * MiB, WS_WDOWN = 17 * MiB, WS_WUQ = 25 * MiB, WS_WUKV = 25 * MiB + 256 * 1024;
constexpr size_t WS_ROPE = 26 * MiB;
constexpr size_t WS_XN = 27 * MiB;
constexpr size_t WS_PROJ = 59 * MiB;
constexpr size_t WS_GLA = 155 * MiB;
constexpr size_t WS_U = 59 * MiB;
constexpr size_t WS_GDEC = 187 * MiB;
constexpr size_t WS_MASK = 188 * MiB;
constexpr size_t WS_VDT = 204 * MiB;
constexpr size_t WS_QM = 212 * MiB;
constexpr size_t WS_KM = 224 * MiB;
constexpr size_t WS_VMT = 236 * MiB;
constexpr size_t WS_END = 244 * MiB;

struct Args { const float* in[20]; float* out; unsigned char* ws; int ph_lo, ph_hi; };

DI float bf2f(bf16_t v) { return __uint_as_float((unsigned)v << 16); }
DI bf16_t f2bf(float f) { unsigned u = __float_as_uint(f); return (bf16_t)((u + 0x7fffu + ((u >> 16) & 1u)) >> 16); }
DI unsigned pk2(float lo, float hi) { return (unsigned)f2bf(lo) | ((unsigned)f2bf(hi) << 16); }
DI f32x4 mfma16(bf16x8 a, bf16x8 b, f32x4 c) { return __builtin_amdgcn_mfma_f32_16x16x32_bf16(a, b, c, 0, 0, 0); }
DI f32x16 mfma32(bf16x8 a, bf16x8 b, f32x16 c) { return __builtin_amdgcn_mfma_f32_32x32x16_bf16(a, b, c, 0, 0, 0); }
DI float wave_sum(float v) {
#pragma unroll
    for (int o = 1; o < 64; o <<= 1) v += __shfl_xor(v, o);
    return v;
}
DI int crow(int r, int hi) { return (r & 3) + 8 * (r >> 2) + 4 * hi; }
#define LDS_FENCE() asm volatile("s_waitcnt lgkmcnt(0)" ::: "memory")

DI void transpose_items(const float* __restrict__ W, int K, int N, bf16_t* __restrict__ WT, int Npad, float* scr, int gw, int ngw, int lane) {
    const int nnb = Npad / 32, items = (K / 32) * nnb;
    for (int it = gw; it < items; it += ngw) {
        const int kb = it / nnb, nb = it % nnb, k0 = kb * 32, n0 = nb * 32;
#pragma unroll 4
        for (int i = 0; i < 16; ++i) {
            const int kk = 2 * i + (lane >> 5), n = n0 + (lane & 31);
            scr[kk * 33 + (lane & 31)] = (n < N) ? W[(size_t)(k0 + kk) * N + n] : 0.f;
        }
        LDS_FENCE();
#pragma unroll 4
        for (int j = 0; j < 16; ++j) {
            const int nn = 2 * j + (lane >> 5), kk = lane & 31;
            WT[(size_t)(n0 + nn) * K + k0 + kk] = f2bf(scr[kk * 33 + nn]);
        }
        LDS_FENCE();
    }
}

DI void rmsnorm_rows(const float* __restrict__ x, const float* __restrict__ gain, bf16_t* __restrict__ out, int gw, int ngw, int lane) {
    for (int row = gw; row < MTOK; row += ngw) {
        const f32x4* xr = (const f32x4*)(x + (size_t)row * DM) + lane;
        f32x4 v[4]; float ss = 0.f;
#pragma unroll
        for (int j = 0; j < 4; ++j) { v[j] = xr[64 * j]; ss += (v[j][0] * v[j][0] + v[j][1] * v[j][1]) + (v[j][2] * v[j][2] + v[j][3] * v[j][3]); }
        ss = wave_sum(ss);
        const float rinv = rsqrtf(ss * (1.f / DM) + RMS_EPS);
        u32x2* o = (u32x2*)(out + (size_t)row * DM) + lane;
#pragma unroll
        for (int j = 0; j < 4; ++j) {
            const f32x4 g = ((const f32x4*)gain)[lane + 64 * j];
            u32x2 w; w[0] = pk2(v[j][0] * rinv * g[0], v[j][1] * rinv * g[1]); w[1] = pk2(v[j][2] * rinv * g[2], v[j][3] * rinv * g[3]);
            o[64 * j] = w;
        }
    }
}

DI void phase_prep(const Args& a, int layer, unsigned char* smem) {
    int tid_ = threadIdx.x; asm volatile("" : "+v"(tid_)); const int tid = tid_, lane = tid & 63, wid = tid >> 6;
    const int gw = blockIdx.x * 8 + wid, ngw = gridDim.x * 8;
    float* scr = (float*)(smem + wid * 4352);
    unsigned char* ws = a.ws;
    transpose_items(a.in[2] + (size_t)layer * DM * DIN, DM, DIN, (bf16_t*)(ws + WS_WIN), NP, scr, gw, ngw, lane);
    transpose_items(a.in[16] + (size_t)layer * DM * DM, DM, DM, (bf16_t*)(ws + WS_WOUT), DM, scr, gw, ngw, lane);
    transpose_items(a.in[18] + (size_t)layer * DM * DFF, DM, DFF, (bf16_t*)(ws + WS_WUP), DFF, scr, gw, ngw, lane);
    transpose_items(a.in[19] + (size_t)layer * DFF * DM, DFF, DM, (bf16_t*)(ws + WS_WDOWN), DM, scr, gw, ngw, lane);
    transpose_items(a.in[11] + (size_t)layer * 192 * 384, 192, 384, (bf16_t*)(ws + WS_WUQ), 384, scr, gw, ngw, lane);
    transpose_items(a.in[12] + (size_t)layer * 128 * 512, 128, 512, (bf16_t*)(ws + WS_WUKV), 512, scr, gw, ngw, lane);
    if (layer == 0) {
        float* cosT = (float*)(ws + WS_ROPE); float* sinT = cosT + SEQ * 16;
        for (int idx = blockIdx.x * 512 + tid; idx < SEQ * 16; idx += gridDim.x * 512) {
            const int t = idx >> 4, i = idx & 15;
            const float inv = powf(10000.f, -(float)i * (1.f / 16.f));
            const float ang = (float)t * inv;
            const double kq = rint((double)ang * 0.15915494309189535);
            const float rf = (float)((double)ang - kq * 6.283185307179586);
            cosT[idx] = __cosf(rf); sinT[idx] = __sinf(rf);
        }
    }
    const float* x = (layer == 0) ? a.in[0] : a.out;
    rmsnorm_rows(x, a.in[1] + layer * DM, (bf16_t*)(ws + WS_XN), gw, ngw, lane);
}

struct EpiBf16 { bf16_t* O; int ldo;
    DI void operator()(int row, int col, f32x4 v) const { u32x2 w; w[0] = pk2(v[0], v[1]); w[1] = pk2(v[2], v[3]); *(u32x2*)(O + (size_t)row * ldo + col) = w; } };
struct EpiResid { const float* R; float* O;
    DI void operator()(int row, int col, f32x4 v) const { const size_t off = (size_t)row * DM + col; const f32x4 r = *(const f32x4*)(R + off); *(f32x4*)(O + off) = r + v; } };
struct EpiRelu2 { bf16_t* O;
    DI void operator()(int row, int col, f32x4 v) const {
        float t0 = fmaxf(v[0], 0.f), t1 = fmaxf(v[1], 0.f), t2 = fmaxf(v[2], 0.f), t3 = fmaxf(v[3], 0.f);
        u32x2 w; w[0] = pk2(t0 * t0, t1 * t1); w[1] = pk2(t2 * t2, t3 * t3); *(u32x2*)(O + (size_t)row * DFF + col) = w; } };

template <class Epi>
DI void gemm_simple(const bf16_t* __restrict__ A, int lda, const bf16_t* __restrict__ Bt, int ldb, int M, int N, int K, const Epi& E) {
    int tid_ = threadIdx.x; asm volatile("" : "+v"(tid_)); const int tid = tid_, lane = tid & 63, wid = tid >> 6, wr = wid >> 2, wc = wid & 3;
    const int nN = (N + 255) / 256, nunits = (M / 128) * nN;
    const int fr = lane & 15, fq = lane >> 4;
    for (int u = blockIdx.x; u < nunits; u += gridDim.x) {
        const int pm = u / nN, pn = u % nN;
        const int m0 = pm * 128 + wr * 64, n0 = pn * 256 + wc * 64;
        if (n0 >= N) continue;
        f32x4 acc[4][4];
#pragma unroll
        for (int i = 0; i < 4; ++i)
#pragma unroll
            for (int j = 0; j < 4; ++j) acc[i][j] = (f32x4){0.f, 0.f, 0.f, 0.f};
        const bf16_t* ap = A + (size_t)(m0 + fr) * lda + fq * 8;
        const bf16_t* bp = Bt + (size_t)(n0 + fr) * ldb + fq * 8;
#pragma unroll 2
        for (int k = 0; k < K; k += 32) {
            bf16x8 af[4], bfr[4];
#pragma unroll
            for (int i = 0; i < 4; ++i) af[i] = *(const bf16x8*)(ap + (size_t)(i * 16) * lda + k);
#pragma unroll
            for (int j = 0; j < 4; ++j) bfr[j] = *(const bf16x8*)(bp + (size_t)(j * 16) * ldb + k);
#pragma unroll
            for (int i = 0; i < 4; ++i)
#pragma unroll
                for (int j = 0; j < 4; ++j) acc[i][j] = mfma16(bfr[j], af[i], acc[i][j]);
        }
#pragma unroll
        for (int i = 0; i < 4; ++i)
#pragma unroll
            for (int j = 0; j < 4; ++j) E(m0 + i * 16 + fr, n0 + j * 16 + 4 * fq, acc[i][j]);
    }
}

DI void transpose_tile_to_vT(const bf16_t* __restrict__ src, int lds_, int colbase, int colstride_h, bf16_t* __restrict__ dstT, int t0, bf16_t* tile, int tid) {
    _Pragma("unroll 2") for (int e = tid; e < 64 * 32; e += 512) {
        const int r = e >> 5, ch = e & 31, h = ch >> 3, dc = ch & 7;
        const u32x4 v = *(const u32x4*)(src + (size_t)(t0 + r) * lds_ + colbase + h * colstride_h + dc * 8);
        *(u32x4*)(tile + r * 264 + ch * 8) = v;
    }
    __syncthreads();
    const int b = t0 >> 13, t = t0 & 8191;
    _Pragma("unroll 2") for (int e = tid; e < 256 * 8; e += 512) {
        const int hd = e >> 3, ch = e & 7;
        unsigned w[4];
#pragma unroll
        for (int j = 0; j < 4; ++j) w[j] = (unsigned)tile[(ch * 8 + 2 * j) * 264 + hd] | ((unsigned)tile[(ch * 8 + 2 * j + 1) * 264 + hd] << 16);
        u32x4 v; v[0] = w[0]; v[1] = w[1]; v[2] = w[2]; v[3] = w[3];
        *(u32x4*)(dstT + ((size_t)(b * 256 + hd)) * SEQ + t + ch * 8) = v;
    }
    __syncthreads();
}

DI void phase_post1(const Args& a, int layer, unsigned char* smem) {
    int tid_ = threadIdx.x; asm volatile("" : "+v"(tid_)); const int tid = tid_, lane = tid & 63, wid = tid >> 6;
    bf16_t* proj = (bf16_t*)(a.ws + WS_PROJ);
    const float* gq = a.in[6] + layer * 64; const float* gk = a.in[7] + layer * 64;
    const float* gcq = a.in[9] + layer * 192; const float* gckv = a.in[10] + layer * 128;
    for (int u = blockIdx.x; u < MTOK / 64; u += gridDim.x) {
        const int t0 = u * 64;
        for (int i = 0; i < 8; ++i) {
            bf16_t* p = proj + (size_t)(t0 + wid * 8 + i) * NP;
#pragma unroll
            for (int h = 0; h < 4; ++h) {
                float v = bf2f(p[C_DQ + h * 64 + lane]); float ss = wave_sum(v * v); float rinv = rsqrtf(ss * (1.f / 64.f) + RMS_EPS);
                p[C_DQ + h * 64 + lane] = f2bf(v * rinv * gq[lane] * DSA_QS);
                v = bf2f(p[C_DK + h * 64 + lane]); ss = wave_sum(v * v); rinv = rsqrtf(ss * (1.f / 64.f) + RMS_EPS);
                p[C_DK + h * 64 + lane] = f2bf(v * rinv * gk[lane]);
            }
            {
                const float c0 = bf2f(p[C_MCQ + lane]), c1 = bf2f(p[C_MCQ + 64 + lane]), c2 = bf2f(p[C_MCQ + 128 + lane]);
                const float ss = wave_sum(c0 * c0 + c1 * c1 + c2 * c2); const float rinv = rsqrtf(ss * (1.f / 192.f) + RMS_EPS);
                p[C_MCQ + lane] = f2bf(c0 * rinv * gcq[lane]); p[C_MCQ + 64 + lane] = f2bf(c1 * rinv * gcq[64 + lane]); p[C_MCQ + 128 + lane] = f2bf(c2 * rinv * gcq[128 + lane]);
            }
            {
                const float c0 = bf2f(p[C_MCKV + lane]), c1 = bf2f(p[C_MCKV + 64 + lane]);
                const float ss = wave_sum(c0 * c0 + c1 * c1); const float rinv = rsqrtf(ss * (1.f / 128.f) + RMS_EPS);
                p[C_MCKV + lane] = f2bf(c0 * rinv * gckv[lane]); p[C_MCKV + 64 + lane] = f2bf(c1 * rinv * gckv[64 + lane]);
            }
        }
        transpose_tile_to_vT(proj, NP, C_DV, 64, (bf16_t*)(a.ws + WS_VDT), t0, (bf16_t*)smem, tid);
    }
}

DI void phase_post2(const Args& a, int layer, unsigned char* smem) {
    int tid_ = threadIdx.x; asm volatile("" : "+v"(tid_)); const int tid = tid_, lane = tid & 63, wid = tid >> 6;
    const bf16_t* proj = (const bf16_t*)(a.ws + WS_PROJ);
    bf16_t* qm = (bf16_t*)(a.ws + WS_QM); bf16_t* km = (bf16_t*)(a.ws + WS_KM);
    const bf16_t* kvraw = (const bf16_t*)(a.ws + WS_MASK);
    const float* gqn = a.in[13] + layer * 96; const float* gkn = a.in[14] + layer * 96;
    const float* cosT = (const float*)(a.ws + WS_ROPE); const float* sinT = cosT + SEQ * 16;
    for (int u = blockIdx.x; u < MTOK / 64; u += gridDim.x) {
        const int t0 = u * 64;
        for (int i = 0; i < 8; ++i) {
            const int row = t0 + wid * 8 + i, t = row & 8191;
            const float cs = cosT[t * 16 + (lane & 15)], sn = sinT[t * 16 + (lane & 15)];
#pragma unroll
            for (int h = 0; h < 4; ++h) {
                {
                    bf16_t* q = qm + (size_t)row * 384 + h * 96;
                    float v0 = bf2f(q[lane]); float v1 = (lane < 32) ? bf2f(q[64 + lane]) : 0.f;
                    const float ss = wave_sum(v0 * v0 + v1 * v1); const float rinv = rsqrtf(ss * (1.f / 96.f) + RMS_EPS);
                    v0 = v0 * rinv * gqn[lane]; v1 = (lane < 32) ? v1 * rinv * gqn[64 + lane] : 0.f;
                    const float pr = __shfl_xor(v1, 16);
                    const float r1 = (lane < 16) ? (v1 * cs - pr * sn) : (v1 * cs + pr * sn);
                    q[lane] = f2bf(v0 * MLA_QS); if (lane < 32) q[64 + lane] = f2bf(r1 * MLA_QS);
                }
                {
                    float v0 = bf2f(kvraw[(size_t)row * 512 + h * 128 + lane]); float v1 = (lane < 32) ? bf2f(proj[(size_t)row * NP + C_MKR + lane]) : 0.f;
                    const float ss = wave_sum(v0 * v0 + v1 * v1); const float rinv = rsqrtf(ss * (1.f / 96.f) + RMS_EPS);
                    v0 = v0 * rinv * gkn[lane]; v1 = (lane < 32) ? v1 * rinv * gkn[64 + lane] : 0.f;
                    const float pr = __shfl_xor(v1, 16);
                    const float r1 = (lane < 16) ? (v1 * cs - pr * sn) : (v1 * cs + pr * sn);
                    bf16_t* k = km + (size_t)row * 384 + h * 96;
                    k[lane] = f2bf(v0); if (lane < 32) k[64 + lane] = f2bf(r1);
                }
            }
        }
        transpose_tile_to_vT(kvraw, 512, 64, 128, (bf16_t*)(a.ws + WS_VMT), t0, (bf16_t*)smem, tid);
    }
}

constexpr int GL_B = 0, GL_GLR = 16384, GL_GU = 20480, GL_BIAS = 24576, GL_QDEC = 24832, GL_KINV = 34048, GL_VT = 43264, GL_SPT = 61696, GL_SC = 80128, GL_O = 89344;
DI float logsig(float z) { return fminf(z, 0.f) - log1pf(expf(-fabsf(z))); }

DI void gla_stage_b(const Args& a, int layer, unsigned char* smem, int h, size_t row0) {
    int tid_ = threadIdx.x; asm volatile("" : "+v"(tid_)); const int tid = tid_;
    const bf16_t* proj = (const bf16_t*)(a.ws + WS_PROJ);
    float* bL = (float*)(smem + GL_B); float* glr = (float*)(smem + GL_GLR); float* gu = (float*)(smem + GL_GU); float* bias = (float*)(smem + GL_BIAS);
    const float* gup = a.in[3] + (size_t)layer * 16 * 256; const float* gb = a.in[4] + layer * 256;
    _Pragma("unroll 2") for (int e = tid; e < 1024; e += 512) { const int c = e >> 4, r = e & 15; glr[e] = bf2f(proj[(row0 + c) * NP + C_GLR + r]); }
    _Pragma("unroll 2") for (int e = tid; e < 1024; e += 512) { const int r = e >> 6, d = e & 63; gu[e] = gup[r * 256 + h * 64 + d]; }
    if (tid < 64) bias[tid] = gb[h * 64 + tid];
    __syncthreads();
    _Pragma("unroll 2") for (int e = tid; e < 4096; e += 512) {
        const int c = e >> 6, d = e & 63; float z = bias[d];
#pragma unroll
        for (int r = 0; r < 16; ++r) z = fmaf(glr[c * 16 + r], gu[r * 64 + d], z);
        bL[e] = logsig(z) * (1.f / 16.f);
    }
    __syncthreads();
    if (tid < 64) { float run = 0.f; for (int c = 0; c < 64; ++c) { run += bL[c * 64 + tid]; bL[c * 64 + tid] = run; } }
    __syncthreads();
}

DI void phase_gla1(const Args& a, int layer, unsigned char* smem) {
    int tid_ = threadIdx.x; asm volatile("" : "+v"(tid_)); const int tid = tid_, lane = tid & 63, wid = tid >> 6;
    const bf16_t* proj = (const bf16_t*)(a.ws + WS_PROJ);
    float* G = (float*)(a.ws + WS_GLA); float* dec = (float*)(a.ws + WS_GDEC);
    float* bL = (float*)(smem + GL_B); bf16_t* kendT = (bf16_t*)(smem + GL_KINV); bf16_t* VT = (bf16_t*)(smem + GL_VT);
    for (int u = blockIdx.x; u < 1024; u += gridDim.x) {
        const int bh = u >> 7, n = u & 127, b = bh >> 2, h = bh & 3;
        const size_t row0 = (size_t)b * SEQ + n * 64;
        gla_stage_b(a, layer, smem, h, row0);
        _Pragma("unroll 2") for (int e = tid; e < 4096; e += 512) {
            const int c = e >> 6, d = e & 63;
            const float k = bf2f(proj[(row0 + c) * NP + C_GK + h * 64 + d]);
            kendT[d * 72 + c] = f2bf(k * expf(bL[63 * 64 + d] - bL[c * 64 + d]));
        }
        _Pragma("unroll 2") for (int e = tid; e < 8192; e += 512) { const int c = e >> 7, v = e & 127; VT[v * 72 + c] = proj[(row0 + c) * NP + C_GV + h * 128 + v]; }
        if (tid < 64) dec[(size_t)u * 64 + tid] = expf(bL[63 * 64 + tid]);
        __syncthreads();
#pragma unroll
        for (int i = 0; i < 4; ++i) {
            const int tile = wid * 4 + i, tv = tile >> 2, td = tile & 3;
            f32x4 acc = {0.f, 0.f, 0.f, 0.f};
#pragma unroll
            for (int ks = 0; ks < 2; ++ks) {
                const bf16x8 av = *(const bf16x8*)(VT + (tv * 16 + (lane & 15)) * 72 + ks * 32 + 8 * (lane >> 4));
                const bf16x8 bv = *(const bf16x8*)(kendT + (td * 16 + (lane & 15)) * 72 + ks * 32 + 8 * (lane >> 4));
                acc = mfma16(av, bv, acc);
            }
#pragma unroll
            for (int r = 0; r < 4; ++r) G[((size_t)u * 128 + tv * 16 + 4 * (lane >> 4) + r) * 64 + td * 16 + (lane & 15)] = acc[r];
        }
        __syncthreads();
    }
}

DI void phase_gla2(const Args& a) {
    float* G = (float*)(a.ws + WS_GLA); const float* dec = (const float*)(a.ws + WS_GDEC);
    for (int e = blockIdx.x * 512 + threadIdx.x; e < 65536; e += gridDim.x * 512) {
        const int bh = e >> 13, vd = e & 8191, d = e & 63;
        float st = 0.f;
        for (int n0 = 0; n0 < 128; n0 += 8) {
            float inc[8], dc[8];
#pragma unroll
            for (int j = 0; j < 8; ++j) { const size_t un = (size_t)bh * 128 + n0 + j; inc[j] = G[un * 8192 + vd]; dc[j] = dec[un * 64 + d]; }
#pragma unroll
            for (int j = 0; j < 8; ++j) { const size_t un = (size_t)bh * 128 + n0 + j; G[un * 8192 + vd] = st; st = fmaf(dc[j], st, inc[j]); }
        }
    }
}

DI void phase_gla3(const Args& a, int layer, unsigned char* smem) {
    int tid_ = threadIdx.x; asm volatile("" : "+v"(tid_)); const int tid = tid_, lane = tid & 63, wid = tid >> 6;
    const bf16_t* proj = (const bf16_t*)(a.ws + WS_PROJ);
    const float* G = (const float*)(a.ws + WS_GLA);
    bf16_t* mix = (bf16_t*)(a.ws + WS_XN);
    const float* gnorm = a.in[5] + layer * 512;
    float* bL = (float*)(smem + GL_B); bf16_t* qdec = (bf16_t*)(smem + GL_QDEC); bf16_t* kinv = (bf16_t*)(smem + GL_KINV); bf16_t* VT = (bf16_t*)(smem + GL_VT);
    bf16_t* SpT = (bf16_t*)(smem + GL_SPT); bf16_t* sc = (bf16_t*)(smem + GL_SC); float* oL = (float*)(smem + GL_O);
    for (int u = blockIdx.x; u < 1024; u += gridDim.x) {
        const int bh = u >> 7, n = u & 127, b = bh >> 2, h = bh & 3;
        const size_t row0 = (size_t)b * SEQ + n * 64;
        gla_stage_b(a, layer, smem, h, row0);
        _Pragma("unroll 2") for (int e = tid; e < 4096; e += 512) {
            const int c = e >> 6, d = e & 63; const float bb = bL[e];
            const float q = bf2f(proj[(row0 + c) * NP + C_GQ + h * 64 + d]), k = bf2f(proj[(row0 + c) * NP + C_GK + h * 64 + d]);
            qdec[c * 72 + d] = f2bf(q * 0.125f * expf(bb)); kinv[c * 72 + d] = f2bf(k * expf(-bb));
        }
        _Pragma("unroll 2") for (int e = tid; e < 8192; e += 512) { const int c = e >> 7, v = e & 127; VT[v * 72 + c] = proj[(row0 + c) * NP + C_GV + h * 128 + v]; }
        _Pragma("unroll 2") for (int e = tid; e < 8192; e += 512) { const int v = e >> 6, d = e & 63; SpT[v * 72 + d] = f2bf(G[(size_t)u * 8192 + e]); }
        _Pragma("unroll 2") for (int e = tid; e < 64 * 72 / 2; e += 512) ((unsigned*)sc)[e] = 0u;
        __syncthreads();
        for (int idx = wid; idx < 10; idx += 8) {
            int tc = 0, rem = idx; while (rem > tc) { rem -= tc + 1; ++tc; } const int ts = rem;
            f32x4 acc = {0.f, 0.f, 0.f, 0.f};
#pragma unroll
            for (int ks = 0; ks < 2; ++ks) {
                const bf16x8 av = *(const bf16x8*)(qdec + (tc * 16 + (lane & 15)) * 72 + ks * 32 + 8 * (lane >> 4));
                const bf16x8 bv = *(const bf16x8*)(kinv + (ts * 16 + (lane & 15)) * 72 + ks * 32 + 8 * (lane >> 4));
                acc = mfma16(av, bv, acc);
            }
            const int s = ts * 16 + (lane & 15);
#pragma unroll
            for (int r = 0; r < 4; ++r) { const int c = tc * 16 + 4 * (lane >> 4) + r; sc[c * 72 + s] = f2bf((s <= c) ? acc[r] : 0.f); }
        }
        __syncthreads();
#pragma unroll
        for (int i = 0; i < 4; ++i) {
            const int tile = wid * 4 + i, tc = tile >> 3, tv = tile & 7;
            f32x4 acc = {0.f, 0.f, 0.f, 0.f};
#pragma unroll
            for (int ks = 0; ks < 2; ++ks) {
                const bf16x8 av = *(const bf16x8*)(sc + (tc * 16 + (lane & 15)) * 72 + ks * 32 + 8 * (lane >> 4));
                const bf16x8 bv = *(const bf16x8*)(VT + (tv * 16 + (lane & 15)) * 72 + ks * 32 + 8 * (lane >> 4));
                acc = mfma16(av, bv, acc);
            }
#pragma unroll
            for (int ks = 0; ks < 2; ++ks) {
                const bf16x8 av = *(const bf16x8*)(qdec + (tc * 16 + (lane & 15)) * 72 + ks * 32 + 8 * (lane >> 4));
                const bf16x8 bv = *(const bf16x8*)(SpT + (tv * 16 + (lane & 15)) * 72 + ks * 32 + 8 * (lane >> 4));
                acc = mfma16(av, bv, acc);
            }
#pragma unroll
            for (int r = 0; r < 4; ++r) oL[(tc * 16 + 4 * (lane >> 4) + r) * 132 + tv * 16 + (lane & 15)] = acc[r];
        }
        __syncthreads();
        {
            const int c = tid >> 3, sub = tid & 7;
            float ov[16]; float ss = 0.f;
#pragma unroll
            for (int j = 0; j < 16; ++j) { ov[j] = oL[c * 132 + sub * 16 + j]; ss += ov[j] * ov[j]; }
            ss += __shfl_xor(ss, 1); ss += __shfl_xor(ss, 2); ss += __shfl_xor(ss, 4);
            const float rinv = rsqrtf(ss * (1.f / 128.f) + RMS_EPS);
            const bf16_t* gp = proj + (row0 + c) * NP + C_GG + h * 128 + sub * 16;
            bf16_t* mp = mix + (row0 + c) * DM + h * 128 + sub * 16;
            unsigned w[8];
#pragma unroll
            for (int j = 0; j < 16; j += 2) {
                const float g0 = bf2f(gp[j]), g1 = bf2f(gp[j + 1]);
                const float s0 = g0 / (1.f + expf(-g0)), s1 = g1 / (1.f + expf(-g1));
                w[j >> 1] = pk2(ov[j] * rinv * gnorm[h * 128 + sub * 16 + j] * s0, ov[j + 1] * rinv * gnorm[h * 128 + sub * 16 + j + 1] * s1);
            }
            u32x4 w0, w1; w0[0] = w[0]; w0[1] = w[1]; w0[2] = w[2]; w0[3] = w[3]; w1[0] = w[4]; w1[1] = w[5]; w1[2] = w[6]; w1[3] = w[7];
            *(u32x4*)mp = w0; *(u32x4*)(mp + 8) = w1;
        }
        __syncthreads();
    }
}

DI unsigned fkey(float s) { const unsigned u = __float_as_uint(s); return (u & 0x80000000u) ? ~u : (u | 0x80000000u); }
DI void dsa_scores(bf16x8 ka, const bf16x8 (&bq)[8], const float (&w)[8], float (&sc)[4]) {
    const f32x4 z = {0.f, 0.f, 0.f, 0.f};
    sc[0] = 0.f; sc[1] = 0.f; sc[2] = 0.f; sc[3] = 0.f;
#pragma unroll
    for (int h = 0; h < 8; ++h) {
        const f32x4 d = mfma16(ka, bq[h], z);
#pragma unroll
        for (int r = 0; r < 4; ++r) sc[r] = __builtin_fmaf(w[h], fmaxf(d[r], 0.f), sc[r]);
    }
#pragma unroll
    for (int r = 0; r < 4; ++r) sc[r] += 0.0f;
}

DI void phase_dsa_select(const Args& a, unsigned char* smem) {
    int tid_ = threadIdx.x; asm volatile("" : "+v"(tid_)); const int tid = tid_, lane = tid & 63, wid = tid >> 6;
    const bf16_t* proj = (const bf16_t*)(a.ws + WS_PROJ);
    unsigned* mask = (unsigned*)(a.ws + WS_MASK);
    unsigned* hist = (unsigned*)smem;
    unsigned* maskL = (unsigned*)smem; unsigned long long* cand = (unsigned long long*)(smem + 16384);
    int* sel = (int*)(smem + 131072); int* cnt = sel + 64;
    const int qrow = lane & 15, kq = lane >> 4;
    for (int u = blockIdx.x; u < 1024; u += gridDim.x) {
        const int b = u & 1, t0 = (511 - (u >> 1)) * 16;
        const size_t g0 = (size_t)b * SEQ + t0;
        unsigned* gmask = mask + g0 * 256;
        if (t0 < 256) {
            _Pragma("unroll 2") for (int e = tid; e < 4096; e += 512) {
                const int r = e >> 8, j = e & 255, t = t0 + r; unsigned w;
                if (32 * j + 31 <= t) w = 0xFFFFFFFFu; else if (32 * j > t) w = 0u; else w = (2u << (t - 32 * j)) - 1u;
                gmask[e] = w;
            }
            continue;
        }
        const bf16_t* qp = proj + (g0 + qrow) * NP;
        bf16x8 bq[8]; float w[8];
#pragma unroll
        for (int h = 0; h < 8; ++h) { bq[h] = *(const bf16x8*)(qp + C_IQ + h * 32 + kq * 8); w[h] = bf2f(qp[C_IW + h]) * 0.0625f; }
        const int tq = t0 + qrow, nkt = t0 / 16 + 1;
        const bf16_t* kbase = proj + ((size_t)b * SEQ + qrow) * NP + C_IK + kq * 8;
        _Pragma("unroll 2") for (int e = tid; e < 16 * 2048; e += 512) hist[e] = 0u;
        __syncthreads();
        for (int kt = wid; kt < nkt; kt += 8) {
            const bf16x8 ka = *(const bf16x8*)(kbase + (size_t)(kt * 16) * NP);
            float sc[4]; dsa_scores(ka, bq, w, sc);
#pragma unroll
            for (int r = 0; r < 4; ++r) {
                const int kp = kt * 16 + kq * 4 + r;
                if (kp <= tq) { const unsigned bin = fkey(sc[r]) >> 20; atomicAdd(&hist[qrow * 2048 + (bin >> 1)], 1u << ((bin & 1) * 16)); }
            }
        }
        __syncthreads();
        for (int rr = 0; rr < 2; ++rr) {
            const int row = wid * 2 + rr; const unsigned* hrow = hist + row * 2048;
            unsigned c = 0;
            for (int i = 0; i < 32; ++i) { const unsigned wv = hrow[lane * 32 + i]; c += (wv & 0xFFFFu) + (wv >> 16); }
            unsigned incl = c;
#pragma unroll
            for (int off = 1; off < 64; off <<= 1) { const unsigned o = __shfl_down(incl, off); if (lane + off < 64) incl += o; }
            const unsigned above = incl - c;
            if (above < 256u && incl >= 256u) {
                unsigned run = above; int bst = lane * 64; unsigned ca = above;
                for (int bin = lane * 64 + 63; bin >= lane * 64; --bin) {
                    const unsigned wv = hrow[bin >> 1]; const unsigned cn = (bin & 1) ? (wv >> 16) : (wv & 0xFFFFu);
                    if (run + cn >= 256u) { bst = bin; ca = run; break; }
                    run += cn;
                }
                sel[row * 2] = bst; sel[row * 2 + 1] = (int)ca;
            }
        }
        __syncthreads();
        const int bst_l = sel[qrow * 2];
        __syncthreads();
        _Pragma("unroll 2") for (int e = tid; e < 4096; e += 512) maskL[e] = 0u;
        if (tid < 16) cnt[tid] = 0;
        __syncthreads();
        for (int kt = wid; kt < nkt; kt += 8) {
            const bf16x8 ka = *(const bf16x8*)(kbase + (size_t)(kt * 16) * NP);
            float sc[4]; dsa_scores(ka, bq, w, sc);
            unsigned bits = 0u;
#pragma unroll
            for (int r = 0; r < 4; ++r) {
                const int kp = kt * 16 + kq * 4 + r;
                if (kp <= tq) {
                    const unsigned key = fkey(sc[r]); const int bin = (int)(key >> 20);
                    if (bin > bst_l) bits |= 1u << r;
                    else if (bin == bst_l) { const int pos = atomicAdd(&cnt[qrow], 1); if (pos < CAND_CAP) cand[qrow * CAND_CAP + pos] = ((unsigned long long)key << 32) | (unsigned long long)(0xFFFFFFFFu - (unsigned)kp); }
                }
            }
            if (bits) atomicOr(&maskL[qrow * 256 + (kt >> 1)], bits << ((kt & 1) * 16 + kq * 4));
        }
        __syncthreads();
        for (int rr = 0; rr < 2; ++rr) {
            const int row = wid * 2 + rr; const int n = min(cnt[row], CAND_CAP); const int need = 256 - sel[row * 2 + 1];
            for (int i = lane; i < n; i += 64) {
                const unsigned long long ci = cand[row * CAND_CAP + i]; int rank = 0;
                for (int m = 0; m < n; ++m) rank += (cand[row * CAND_CAP + m] > ci) ? 1 : 0;
                if (rank < need) { const unsigned kp = 0xFFFFFFFFu - (unsigned)(ci & 0xFFFFFFFFull); atomicOr(&maskL[row * 256 + (kp >> 5)], 1u << (kp & 31)); }
            }
        }
        __syncthreads();
        _Pragma("unroll 2") for (int e = tid; e < 4096; e += 512) gmask[e] = maskL[e];
        __syncthreads();
    }
}

template <int DQ, bool USE_MASK>
DI void attn_wave(const bf16_t* __restrict__ Q, int ldq, int qcol, const bf16_t* __restrict__ K, int ldk, int kcol, const bf16_t* __restrict__ VTb,
                  const unsigned* __restrict__ mask, int b, int qb, int lane, bf16_t* __restrict__ mix, int mixcol, const float* __restrict__ gain) {
    const int r32 = lane & 31, hi = lane >> 5;
    const size_t rb = (size_t)b * SEQ; const int q0 = qb * 32;
    constexpr int NS = DQ / 16;
    bf16x8 qf[NS];
#pragma unroll
    for (int s = 0; s < NS; ++s) qf[s] = *(const bf16x8*)(Q + (rb + q0 + r32) * ldq + qcol + 16 * s + 8 * hi);
    f32x16 o0, o1;
#pragma unroll
    for (int r = 0; r < 16; ++r) { o0[r] = 0.f; o1[r] = 0.f; }
    float m = -1e30f, l = 0.f;
    const unsigned* mrow = mask + (rb + q0 + r32) * 256;
    for (int kt = 0; kt <= qb; ++kt) {
        f32x16 p;
#pragma unroll
        for (int r = 0; r < 16; ++r) p[r] = 0.f;
        const bf16_t* kp = K + (rb + kt * 32 + r32) * ldk + kcol + 8 * hi;
#pragma unroll
        for (int s = 0; s < NS; ++s) { const bf16x8 kf = *(const bf16x8*)(kp + 16 * s); p = mfma32(kf, qf[s], p); }
        unsigned vbits;
        if (USE_MASK) vbits = mrow[kt];
        else vbits = (kt < qb) ? 0xFFFFFFFFu : ((2u << r32) - 1u);
        float pm = -1e30f;
#pragma unroll
        for (int r = 0; r < 16; ++r) { const bool v = (vbits >> crow(r, hi)) & 1u; pm = fmaxf(pm, v ? p[r] : -1e30f); }
        pm = fmaxf(pm, __shfl_xor(pm, 32));
        const float mn = fmaxf(m, pm); const float alpha = __builtin_amdgcn_exp2f(m - mn); m = mn;
        float ls = 0.f;
#pragma unroll
        for (int r = 0; r < 16; ++r) { const bool v = (vbits >> crow(r, hi)) & 1u; const float e = v ? __builtin_amdgcn_exp2f(p[r] - mn) : 0.f; p[r] = e; ls += e; }
        l = l * alpha + ls;
#pragma unroll
        for (int r = 0; r < 16; ++r) { o0[r] *= alpha; o1[r] *= alpha; }
        bf16x8 pk[2];
#pragma unroll
        for (int s = 0; s < 2; ++s) {
            u32x4 w; w[0] = pk2(p[8 * s], p[8 * s + 1]); w[1] = pk2(p[8 * s + 2], p[8 * s + 3]); w[2] = pk2(p[8 * s + 4], p[8 * s + 5]); w[3] = pk2(p[8 * s + 6], p[8 * s + 7]);
            pk[s] = __builtin_bit_cast(bf16x8, w);
        }
#pragma unroll
        for (int s = 0; s < 2; ++s) {
            const bf16_t* v0p = VTb + (size_t)r32 * SEQ + kt * 32 + 16 * s + 4 * hi;
            const bf16_t* v1p = v0p + (size_t)32 * SEQ;
            const u32x2 a0 = *(const u32x2*)v0p, a1 = *(const u32x2*)(v0p + 8);
            const u32x2 c0 = *(const u32x2*)v1p, c1 = *(const u32x2*)(v1p + 8);
            u32x4 f0, f1; f0[0] = a0[0]; f0[1] = a0[1]; f0[2] = a1[0]; f0[3] = a1[1]; f1[0] = c0[0]; f1[1] = c0[1]; f1[2] = c1[0]; f1[3] = c1[1];
            o0 = mfma32(__builtin_bit_cast(bf16x8, f0), pk[s], o0);
            o1 = mfma32(__builtin_bit_cast(bf16x8, f1), pk[s], o1);
        }
    }
    l += __shfl_xor(l, 32);
    const float linv = 1.f / l;
    float ss = 0.f;
#pragma unroll
    for (int r = 0; r < 16; ++r) { o0[r] *= linv; o1[r] *= linv; ss += o0[r] * o0[r] + o1[r] * o1[r]; }
    ss += __shfl_xor(ss, 32);
    const float rinv = rsqrtf(ss * (1.f / 64.f) + RMS_EPS);
    bf16_t* mp = mix + (rb + q0 + r32) * DM + mixcol;
#pragma unroll
    for (int g = 0; g < 4; ++g) {
        const int d0 = 8 * g + 4 * hi;
        u32x2 w;
        w[0] = pk2(o0[4 * g] * rinv * gain[d0], o0[4 * g + 1] * rinv * gain[d0 + 1]); w[1] = pk2(o0[4 * g + 2] * rinv * gain[d0 + 2], o0[4 * g + 3] * rinv * gain[d0 + 3]);
        *(u32x2*)(mp + d0) = w;
        w[0] = pk2(o1[4 * g] * rinv * gain[32 + d0], o1[4 * g + 1] * rinv * gain[32 + d0 + 1]); w[1] = pk2(o1[4 * g + 2] * rinv * gain[32 + d0 + 2], o1[4 * g + 3] * rinv * gain[32 + d0 + 3]);
        *(u32x2*)(mp + 32 + d0) = w;
    }
}

DI void phase_attn_mla(const Args& a, int layer) {
    const int lane = threadIdx.x & 63, wid = threadIdx.x >> 6;
    const bf16_t* qm = (const bf16_t*)(a.ws + WS_QM); const bf16_t* km = (const bf16_t*)(a.ws + WS_KM); const bf16_t* vmT = (const bf16_t*)(a.ws + WS_VMT);
    bf16_t* mix = (bf16_t*)(a.ws + WS_XN);
    for (int u = blockIdx.x * 8 + wid; u < 2048; u += gridDim.x * 8) {
        const int kk = u >> 3, w = u & 7, b = w >> 2, h = w & 3, qb = 255 - ((kk + 32 * w) & 255);
        attn_wave<96, false>(qm, 384, h * 96, km, 384, h * 96, vmT + (size_t)(w * 64) * SEQ, (const unsigned*)(a.ws + WS_MASK), b, qb, lane, mix, 768 + h * 64, a.in[15] + layer * 256 + h * 64);
    }
}
DI void phase_attn_dsa(const Args& a, int layer) {
    const int lane = threadIdx.x & 63, wid = threadIdx.x >> 6;
    const bf16_t* proj = (const bf16_t*)(a.ws + WS_PROJ); const bf16_t* vdT = (const bf16_t*)(a.ws + WS_VDT);
    bf16_t* mix = (bf16_t*)(a.ws + WS_XN);
    for (int u = blockIdx.x * 8 + wid; u < 2048; u += gridDim.x * 8) {
        const int kk = u >> 3, w = u & 7, b = w >> 2, h = w & 3, qb = 255 - ((kk + 32 * w) & 255);
        attn_wave<64, true>(proj, NP, C_DQ + h * 64, proj, NP, C_DK + h * 64, vdT + (size_t)(w * 64) * SEQ, (const unsigned*)(a.ws + WS_MASK), b, qb, lane, mix, 512 + h * 64, a.in[8] + layer * 256 + h * 64);
    }
}

namespace pg8 {
#define PG8_LAS __attribute__((address_space(3)))
typedef unsigned short bf16_t;
typedef short bf16x8 __attribute__((ext_vector_type(8)));
typedef float f32x4 __attribute__((ext_vector_type(4)));
typedef unsigned u32x4 __attribute__((ext_vector_type(4)));
constexpr int BM = 256, BK = 64, HALF = 128, HTB = HALF * BK * 2  , STAGE_BYTES = 8 * HTB, NXCD = 8, WGM = 8;

__host__ __device__ __forceinline__ int lds_byte(int r, int c) { const int st = (r >> 4) * 2 + (c >> 5), rr = r & 15, cc = c & 31, ob = rr * 64 + cc * 2; return st * 1024 + (ob ^ (((ob >> 9) & 1) << 5)); }
__host__ __device__ __forceinline__ void stage_rc(int b, int& R, int& C) { const int st = b / 1024, sb = b % 1024, swz = sb ^ (((sb >> 9) & 1) << 5); R = (st >> 1) * 16 + swz / 64; C = (st & 1) * 32 + (swz % 64) / 2; }
__host__ __device__ __forceinline__ int perm32(int rho) { const int n = rho >> 4, i = rho & 15; return 8 * (i >> 2) + 4 * n + (i & 3); }

struct Unit { int pm, pn; };
struct Gemm { const bf16_t* A; const bf16_t* Bt; int M, N, K; };

struct StaticOrder {
    int nM, nN, nwg, G, c;
    __host__ __device__ void init(int M, int N, int G_, int c_) { nM = M / BM; nN = N / BM; nwg = nM * nN; G = G_; c = c_; }
    __host__ __device__ bool next(int i, Unit& u) const {
        const long L = (long)i * G + c; if (L >= nwg) return false;
        int wgid = (int)L; { const int q = nwg / NXCD, r = nwg % NXCD, xcd = wgid % NXCD, off = wgid / NXCD; wgid = (xcd < r ? xcd * (q + 1) : r * (q + 1) + (xcd - r) * q) + off; }
        const int nig = WGM * nN, gid = wgid / nig, fm = gid * WGM, gsz = (nM - fm) < WGM ? (nM - fm) : WGM;
        u.pm = fm + ((wgid % nig) % gsz); u.pn = (wgid % nig) / gsz; return true;
    }
    __device__ __forceinline__ void a_ready(const Unit&) const {}
    __device__ __forceinline__ void done(const Unit&) const {}
};
__device__ __forceinline__ unsigned cvt_pk_bf16(float lo, float hi) { unsigned r; asm volatile("v_cvt_pk_bf16_f32 %0, %1, %2" : "=v"(r) : "v"(lo), "v"(hi)); return r; }
typedef float f32x2 __attribute__((ext_vector_type(2)));

template <int ACT  > struct EpiBf16 {
    static constexpr bool PERM = true, AFTER_DRAIN = false;
    bf16_t* O; int ldc;
    __device__ __forceinline__ void operator()(const f32x4 (&acc)[2][2][4][2], const Unit& u, int wr, int wc, int fr, int fq) const {
        const int row0 = u.pm * BM + wr * 64 + fr; const int col0 = u.pn * BM + wc * 32 + 8 * fq;
#pragma unroll
        for (int ai = 0; ai < 2; ++ai)
#pragma unroll
            for (int m = 0; m < 4; ++m) { bf16_t* rowp = O + (size_t)(row0 + ai * HALF + m * 16) * ldc + col0;
#pragma unroll
                for (int bj = 0; bj < 2; ++bj) { f32x4 v0 = acc[ai][bj][m][0], v1 = acc[ai][bj][m][1];
                    if (ACT == 2) {
#pragma unroll
                        for (int e = 0; e < 4; ++e) { const float a0 = fmaxf(v0[e], 0.f), a1 = fmaxf(v1[e], 0.f); v0[e] = a0 * a0; v1[e] = a1 * a1; } }
                    u32x4 w; w.x = cvt_pk_bf16(v0[0], v0[1]); w.y = cvt_pk_bf16(v0[2], v0[3]); w.z = cvt_pk_bf16(v1[0], v1[1]); w.w = cvt_pk_bf16(v1[2], v1[3]);
                    *(u32x4*)(rowp + bj * HALF) = w; } }
    }
};
struct EpiResid {
    static constexpr bool PERM = false, AFTER_DRAIN = false;
    const float* R; float* out; int ldc;
    __device__ __forceinline__ void operator()(const f32x4 (&acc)[2][2][4][2], const Unit& u, int wr, int wc, int fr, int fq) const {
        const int col0 = u.pn * BM + wc * 32 + 4 * fq;
#pragma unroll
        for (int ai = 0; ai < 2; ++ai)
#pragma unroll
            for (int m = 0; m < 4; ++m) { const size_t off = (size_t)(u.pm * BM + ai * HALF + wr * 64 + m * 16 + fr) * ldc + col0;
#pragma unroll
                for (int bj = 0; bj < 2; ++bj)
#pragma unroll
                    for (int n = 0; n < 2; ++n) { const f32x4 r = *(const f32x4*)(R + off + bj * HALF + n * 16); *(f32x4*)(out + off + bj * HALF + n * 16) = r + acc[ai][bj][m][n]; }
                asm volatile("" ::: "memory"); }
    }
};

template <class Epi, class Sched, bool ALIGN_EPI = false, bool SP2 = false>
__device__ __forceinline__ void gemm_phase(PG8_LAS unsigned char* lds, const Gemm g, const Sched& S, const Epi& E) {
    const int tid = threadIdx.x, wid = __builtin_amdgcn_readfirstlane(tid >> 6), lane = tid & 63, wr = wid >> 2, wc = wid & 3, fr = lane & 15, fq = lane >> 4;
    const int K = g.K, nt = K / BK;
    unsigned voffA[2], voffB[2];
#pragma unroll
    for (int i = 0; i < 2; ++i) { int R, C; stage_rc(tid * 16 + i * 8192, R, C); const int Rb = Epi::PERM ? ((R & ~31) + perm32(R & 31)) : R;
        voffA[i] = (unsigned)(R * K + C) * 2u; voffB[i] = (unsigned)(Rb * K + C) * 2u; }
    const size_t kstep = (size_t)(BK * 2);
    const size_t hstep = (size_t)HALF * K * 2;
    const size_t tstep = 2 * hstep;
    const unsigned ldsw = (unsigned)wid * 1024u;
    const int aoff = lds_byte(wr * 64 + fr, fq * 8), boff = lds_byte(wc * 32 + fr, fq * 8);
#define PG8_SA(b, h) (((b) * 2 + (h)) * HTB)
#define PG8_SB(b, h) ((4 + (b) * 2 + (h)) * HTB)
#define PG8_STAGE(bufoff, gbase, voff) do { _Pragma("unroll") for (int _i = 0; _i < 2; ++_i) \
        __builtin_amdgcn_global_load_lds((const unsigned*)((const char*)(gbase) + (voff)[_i]), (PG8_LAS unsigned*)(lds + (bufoff) + ldsw + _i * 8192), 16, 0, 0); } while (0)
#define PG8_LDA(dst, b, h) do { _Pragma("unroll") for (int m = 0; m < 4; ++m) _Pragma("unroll") for (int k = 0; k < 2; ++k) dst[m][k] = *(const PG8_LAS bf16x8*)(lds + PG8_SA(b, h) + aoff + m * 2048 + k * 1024); } while (0)
#define PG8_LDB(dst, b, h) do { _Pragma("unroll") for (int n = 0; n < 2; ++n) _Pragma("unroll") for (int k = 0; k < 2; ++k) dst[n][k] = *(const PG8_LAS bf16x8*)(lds + PG8_SB(b, h) + boff + n * 2048 + k * 1024); } while (0)
#define PG8_MMA(ai, bj, At, Bt) do { __builtin_amdgcn_s_setprio(1); _Pragma("unroll") for (int m = 0; m < 4; ++m) _Pragma("unroll") for (int n = 0; n < 2; ++n) _Pragma("unroll") for (int k = 0; k < 2; ++k) \
        acc[ai][bj][m][n] = __builtin_amdgcn_mfma_f32_16x16x32_bf16(Bt[n][k], At[m][k], acc[ai][bj][m][n], 0, 0, 0); __builtin_amdgcn_s_setprio(0); } while (0)
#define PG8_WAIT_V(n) asm volatile("s_waitcnt vmcnt(" #n ")" ::: "memory")
#define PG8_WAIT_L(n) asm volatile("s_waitcnt lgkmcnt(" #n ")" ::: "memory")
#define PG8_BAR __builtin_amdgcn_s_barrier()
#define PG8_SCHED __builtin_amdgcn_sched_barrier(0)
    Unit cur, nxt; int ui = 0;
    if (!S.next(0, cur)) return;
    f32x4 acc[2][2][4][2];
#pragma unroll
    for (int a = 0; a < 2; ++a)
#pragma unroll
        for (int b = 0; b < 2; ++b)
#pragma unroll
            for (int m = 0; m < 4; ++m)
#pragma unroll
                for (int n = 0; n < 2; ++n) acc[a][b][m][n] = (f32x4){0.f, 0.f, 0.f, 0.f};
    bf16x8 At[4][2], B0[2][2], B1[2][2];
    const char* cA = (const char*)g.A + (size_t)cur.pm * tstep; const char* cB = (const char*)g.Bt + (size_t)cur.pn * tstep;
    S.a_ready(cur);
    if constexpr (SP2) {
        PG8_STAGE(PG8_SB(0, 0), cB, voffB); PG8_STAGE(PG8_SB(0, 1), cB + hstep, voffB); PG8_STAGE(PG8_SA(0, 0), cA, voffA); PG8_STAGE(PG8_SA(0, 1), cA + hstep, voffA);
        if (wr == 1) PG8_BAR;
        PG8_WAIT_V(2); PG8_BAR;
        PG8_STAGE(PG8_SB(1, 0), cB + kstep, voffB); PG8_STAGE(PG8_SA(1, 0), cA + kstep, voffA); PG8_STAGE(PG8_SB(1, 1), cB + hstep + kstep, voffB);
        PG8_WAIT_V(6); PG8_BAR;
    } else {
        PG8_STAGE(PG8_SB(0, 0), cB, voffB); PG8_STAGE(PG8_SA(0, 0), cA, voffA); PG8_STAGE(PG8_SB(0, 1), cB + hstep, voffB); PG8_STAGE(PG8_SA(0, 1), cA + hstep, voffA);
        if (wr == 1) PG8_BAR;
        PG8_WAIT_V(4); PG8_BAR;
        PG8_STAGE(PG8_SB(1, 0), cB + kstep, voffB); PG8_STAGE(PG8_SA(1, 0), cA + kstep, voffA); PG8_STAGE(PG8_SB(1, 1), cB + hstep + kstep, voffB);
        PG8_WAIT_V(6); PG8_BAR;
    }
    for (;;) {
        const bool has_next = S.next(ui + 1, nxt);
        const char* nA = has_next ? (const char*)g.A + (size_t)nxt.pm * tstep : cA; const char* nB = has_next ? (const char*)g.Bt + (size_t)nxt.pn * tstep : cB;
        for (int t = 0; t < nt; t += 2) {
            const bool last = (t == nt - 2);
            const char* a1 = cA + (size_t)(t + 1) * kstep;
            const char* a2 = last ? nA : cA + (size_t)(t + 2) * kstep; const char* b2 = last ? nB : cB + (size_t)(t + 2) * kstep;
            const char* a3 = a2 + kstep; const char* b3 = b2 + kstep;
            if (last && has_next) S.a_ready(nxt);
            if constexpr (SP2) {
            PG8_LDB(B0, 0, 0); PG8_LDB(B1, 0, 1); PG8_SCHED; PG8_LDA(At, 0, 0); PG8_STAGE(PG8_SA(1, 1), a1 + hstep, voffA);
            PG8_WAIT_V(8); PG8_WAIT_L(0); PG8_BAR; PG8_MMA(0, 0, At, B0); PG8_MMA(0, 1, At, B1); PG8_BAR; PG8_SCHED;
            PG8_LDA(At, 0, 1); PG8_STAGE(PG8_SB(0, 0), b2, voffB); PG8_STAGE(PG8_SB(0, 1), b2 + hstep, voffB); PG8_STAGE(PG8_SA(0, 0), a2, voffA);
            PG8_WAIT_V(8); PG8_WAIT_L(0); PG8_BAR; PG8_MMA(1, 0, At, B0); PG8_MMA(1, 1, At, B1); PG8_BAR; PG8_SCHED;
            PG8_LDB(B0, 1, 0); PG8_LDB(B1, 1, 1); PG8_SCHED; PG8_LDA(At, 1, 0); PG8_STAGE(PG8_SA(0, 1), a2 + hstep, voffA);
            PG8_WAIT_V(8); PG8_WAIT_L(0); PG8_BAR; PG8_MMA(0, 0, At, B0); PG8_MMA(0, 1, At, B1); PG8_BAR; PG8_SCHED;
            PG8_LDA(At, 1, 1); PG8_STAGE(PG8_SB(1, 0), b3, voffB); PG8_STAGE(PG8_SB(1, 1), b3 + hstep, voffB); PG8_STAGE(PG8_SA(1, 0), a3, voffA);
            PG8_WAIT_V(8); PG8_WAIT_L(0); PG8_BAR; PG8_MMA(1, 0, At, B0); PG8_MMA(1, 1, At, B1); PG8_BAR; PG8_SCHED;
            } else {
            PG8_LDB(B0, 0, 0); PG8_SCHED; PG8_LDA(At, 0, 0); PG8_STAGE(PG8_SA(1, 1), a1 + hstep, voffA);
            PG8_WAIT_L(8); PG8_BAR; PG8_WAIT_L(0); PG8_MMA(0, 0, At, B0); PG8_BAR; PG8_SCHED;
            PG8_LDB(B1, 0, 1); PG8_STAGE(PG8_SB(0, 0), b2, voffB);
            PG8_BAR; PG8_WAIT_L(0); PG8_MMA(0, 1, At, B1); PG8_BAR;
            PG8_LDA(At, 0, 1); PG8_STAGE(PG8_SA(0, 0), a2, voffA);
            PG8_BAR; PG8_WAIT_L(0); PG8_MMA(1, 0, At, B0); PG8_BAR; PG8_SCHED;
            PG8_STAGE(PG8_SB(0, 1), b2 + hstep, voffB);
            PG8_WAIT_V(6); PG8_BAR; PG8_MMA(1, 1, At, B1); PG8_BAR;
            PG8_LDB(B0, 1, 0); PG8_SCHED; PG8_LDA(At, 1, 0); PG8_STAGE(PG8_SA(0, 1), a2 + hstep, voffA);
            PG8_WAIT_L(8); PG8_BAR; PG8_WAIT_L(0); PG8_MMA(0, 0, At, B0); PG8_BAR; PG8_SCHED;
            PG8_LDB(B1, 1, 1); PG8_STAGE(PG8_SB(1, 0), b3, voffB);
            PG8_BAR; PG8_WAIT_L(0); PG8_MMA(0, 1, At, B1); PG8_BAR;
            PG8_LDA(At, 1, 1); PG8_STAGE(PG8_SA(1, 0), a3, voffA);
            PG8_BAR; PG8_WAIT_L(0); PG8_MMA(1, 0, At, B0); PG8_BAR; PG8_SCHED;
            PG8_STAGE(PG8_SB(1, 1), b3 + hstep, voffB);
            PG8_WAIT_V(6); PG8_BAR; PG8_MMA(1, 1, At, B1); PG8_BAR;
            }
        }
        if constexpr (ALIGN_EPI) { if (wr == 0) PG8_BAR; }
        if constexpr (!Epi::AFTER_DRAIN) { E(acc, cur, wr, wc, fr, fq); S.done(cur); }
        if (!has_next) break;
#pragma unroll
        for (int a = 0; a < 2; ++a)
#pragma unroll
            for (int b = 0; b < 2; ++b)
#pragma unroll
                for (int m = 0; m < 4; ++m)
#pragma unroll
                    for (int n = 0; n < 2; ++n) acc[a][b][m][n] = (f32x4){0.f, 0.f, 0.f, 0.f};
        cur = nxt; cA = nA; cB = nB; ++ui;
        if constexpr (ALIGN_EPI) { if (wr == 1) PG8_BAR; }
    }
    PG8_WAIT_V(0);
    if constexpr (!ALIGN_EPI) { if (wr == 0) PG8_BAR; }
    PG8_BAR;
    if constexpr (Epi::AFTER_DRAIN) { E.fused(acc, cur, wr, wc, fr, fq, lds, wid, lane); S.done(cur); }
#undef PG8_SA
#undef PG8_SB
#undef PG8_STAGE
#undef PG8_LDA
#undef PG8_LDB
#undef PG8_MMA
#undef PG8_WAIT_V
#undef PG8_WAIT_L
#undef PG8_BAR
#undef PG8_SCHED
}
}

template <int LAYER>
DI void layer_program(const Args& a, unsigned char* smem, cg::grid_group& grid) {
    constexpr int layer = LAYER, pb = LAYER * NPH;
    unsigned char* ws = a.ws;
#define IN(k) (a.ph_lo <= (pb + (k)) && (pb + (k)) < a.ph_hi)
#define SEAM(k) do { if (IN(k) && IN((k) + 1)) grid.sync(); } while (0)
    if (IN(0)) phase_prep(a, layer, smem);
    SEAM(0);
    if (IN(1)) { pg8::Gemm g{(const bf16_t*)(ws + WS_XN), (const bf16_t*)(ws + WS_WIN), MTOK, NP, DM}; pg8::StaticOrder S; S.init(MTOK, NP, (int)gridDim.x, (int)blockIdx.x);
                 pg8::EpiBf16<0> E{(bf16_t*)(ws + WS_PROJ), NP}; pg8::gemm_phase<pg8::EpiBf16<0>, pg8::StaticOrder, true, true>((PG8_LAS unsigned char*)smem, g, S, E); }
    SEAM(1);
    if (IN(2)) phase_post1(a, layer, smem);
    SEAM(2);
    if (IN(3)) {
        EpiBf16 E1{(bf16_t*)(ws + WS_QM), 384}; gemm_simple((const bf16_t*)(ws + WS_PROJ) + C_MCQ, NP, (const bf16_t*)(ws + WS_WUQ), 192, MTOK, 384, 192, E1);
        EpiBf16 E2{(bf16_t*)(ws + WS_MASK), 512}; gemm_simple((const bf16_t*)(ws + WS_PROJ) + C_MCKV, NP, (const bf16_t*)(ws + WS_WUKV), 128, MTOK, 512, 128, E2);
    }
    SEAM(3);
    if (IN(4)) phase_post2(a, layer, smem);
    SEAM(4);
    if (IN(5)) { phase_gla1(a, layer, smem); phase_dsa_select(a, smem); phase_attn_mla(a, layer); }
    SEAM(5);
    if (IN(6)) { phase_gla2(a); phase_attn_dsa(a, layer); }
    SEAM(6);
    if (IN(7)) phase_gla3(a, layer, smem);
    SEAM(7);
    if (IN(8)) { pg8::Gemm g{(const bf16_t*)(ws + WS_XN), (const bf16_t*)(ws + WS_WOUT), MTOK, DM, DM}; pg8::StaticOrder S; S.init(MTOK, DM, (int)gridDim.x, (int)blockIdx.x);
                 pg8::EpiResid E{layer == 0 ? a.in[0] : a.out, a.out, DM}; pg8::gemm_phase<pg8::EpiResid, pg8::StaticOrder, true, true>((PG8_LAS unsigned char*)smem, g, S, E); }
    SEAM(8);
    if (IN(9)) { int tid_ = threadIdx.x; asm volatile("" : "+v"(tid_)); rmsnorm_rows(a.out, a.in[17] + layer * DM, (bf16_t*)(ws + WS_XN), blockIdx.x * 8 + (tid_ >> 6), gridDim.x * 8, tid_ & 63); }
    SEAM(9);
    if (IN(10)) { pg8::Gemm g{(const bf16_t*)(ws + WS_XN), (const bf16_t*)(ws + WS_WUP), MTOK, DFF, DM}; pg8::StaticOrder S; S.init(MTOK, DFF, (int)gridDim.x, (int)blockIdx.x);
                  pg8::EpiBf16<2> E{(bf16_t*)(ws + WS_U), DFF}; pg8::gemm_phase<pg8::EpiBf16<2>, pg8::StaticOrder, true, true>((PG8_LAS unsigned char*)smem, g, S, E); }
    SEAM(10);
    if (IN(11)) { pg8::Gemm g{(const bf16_t*)(ws + WS_U), (const bf16_t*)(ws + WS_WDOWN), MTOK, DM, DFF}; pg8::StaticOrder S; S.init(MTOK, DM, (int)gridDim.x, (int)blockIdx.x);
                  pg8::EpiResid E{a.out, a.out, DM}; pg8::gemm_phase<pg8::EpiResid, pg8::StaticOrder, true, true>((PG8_LAS unsigned char*)smem, g, S, E); }
#undef IN
#undef SEAM
}

__global__ void __launch_bounds__(512, 2) fwd_kernel(Args a) {
    extern __shared__ __attribute__((aligned(16))) unsigned char smem[];
    cg::grid_group grid = cg::this_grid();
#define IN(k) (a.ph_lo <= (k) && (k) < a.ph_hi)
#define SEAM(k) do { if (IN(k) && IN((k) + 1)) grid.sync(); } while (0)
    layer_program<0>(a, smem, grid);
    SEAM(NPH - 1);
    layer_program<1>(a, smem, grid);
#undef IN
#undef SEAM
}

extern "C" void kernel_launch(void* const* d_in, const int* in_sizes, int n_in, void* d_out, int out_size, void* d_ws, size_t ws_size, hipStream_t stream) {
    static int grid_blocks = 0;
    if (grid_blocks == 0) {
        if (n_in != 20 || ws_size < WS_END) { fprintf(stderr, "kernel_launch: unexpected n_in %d / ws_size %zu\n", n_in, ws_size); grid_blocks = -1; return; }
        int dev = 0, cus = 0, per_cu = 0;
        hipGetDevice(&dev);
        hipDeviceGetAttribute(&cus, hipDeviceAttributeMultiprocessorCount, dev);
        hipFuncSetAttribute((const void*)fwd_kernel, hipFuncAttributeMaxDynamicSharedMemorySize, LDS_BYTES);
        hipOccupancyMaxActiveBlocksPerMultiprocessor(&per_cu, (const void*)fwd_kernel, 512, LDS_BYTES);
        if (per_cu < 1) { fprintf(stderr, "kernel_launch: occupancy query says %d blocks/CU\n", per_cu); per_cu = 1; }
        if (per_cu > 1) per_cu = 1;
        grid_blocks = cus * per_cu;
        (void)hipGetLastError();
    }
    if (grid_blocks < 0) return;
    Args a{};
    for (int i = 0; i < 20; ++i) a.in[i] = (const float*)d_in[i];
    a.out = (float*)d_out; a.ws = (unsigned char*)d_ws;
#if N_LAUNCH_MODE == 1
    a.ph_lo = 0; a.ph_hi = 2 * NPH;
    void* args[] = {&a};
    hipError_t e = hipLaunchCooperativeKernel((const void*)fwd_kernel, dim3(grid_blocks), dim3(512), args, LDS_BYTES, stream);
    if (e != hipSuccess) fprintf(stderr, "cooperative launch failed: %s (grid %d)\n", hipGetErrorString(e), grid_blocks);
#else
    for (int ph = 0; ph < 2 * NPH; ++ph) {
        a.ph_lo = ph; a.ph_hi = ph + 1;
        hipLaunchKernelGGL(fwd_kernel, dim3(grid_blocks), dim3(512), LDS_BYTES, stream, a);
    }
#endif
}
```

```cpp
#include <hip/hip_runtime.h>
#include <hip/hip_cooperative_groups.h>
#include <cstdio>
#include <cstdint>
namespace cg = cooperative_groups;

#ifndef PROBE_DUP
#define PROBE_DUP 0
#endif
#ifndef PROBE_VAR
#define PROBE_VAR 1
#endif
#ifndef N_LAUNCH_MODE
#define N_LAUNCH_MODE 1
#endif

#define DI __device__ __forceinline__
typedef unsigned short bf16_t;
typedef short bf16x8 __attribute__((ext_vector_type(8)));
typedef short bf16x4 __attribute__((ext_vector_type(4)));
typedef float f32x4 __attribute__((ext_vector_type(4)));
typedef float f32x16 __attribute__((ext_vector_type(16)));
typedef unsigned u32x4 __attribute__((ext_vector_type(4)));
typedef unsigned u32x2 __attribute__((ext_vector_type(2)));

constexpr int SEQ = 8192, MTOK = 16384, DM = 1024, NP = 3072, DIN = 2968, DFF = 4096;
constexpr int C_GQ = 0, C_GK = 256, C_GV = 512, C_GG = 1024, C_GLR = 1536, C_DQ = 1552, C_DK = 1808, C_DV = 2064,
              C_IQ = 2320, C_IK = 2576, C_IW = 2608, C_MCQ = 2616, C_MCKV = 2808, C_MKR = 2936;
constexpr float RMS_EPS = 1e-6f;
constexpr float LOG2E = 1.4426950408889634f;
constexpr float DSA_QS = 0.125f * LOG2E;
constexpr float MLA_QS = 0.10206207261596577f * LOG2E;
constexpr int NPH = 9;
constexpr int LDS_BYTES = 147456;
constexpr int CAND_CAP = 768;

constexpr size_t MiB = 1u << 20;
constexpr size_t WS_BAR = 16384, WS_BAR_BYTES = 65536;
constexpr size_t WS_WIN = 1 * MiB, WS_WOUT = 7 * MiB, WS_WUP = 9 * MiB, WS_WDOWN = 17 * MiB, WS_WUQ = 25 * MiB, WS_WUKV = 25 * MiB + 256 * 1024;
constexpr size_t WS_ROPE = 26 * MiB;
constexpr size_t WS_XN = 27 * MiB;
constexpr size_t WS_PROJ = 59 * MiB;
constexpr size_t WS_GLA = 155 * MiB;
constexpr size_t WS_U = 59 * MiB;
constexpr size_t WS_GDEC = 187 * MiB;
constexpr size_t WS_MASK = 188 * MiB;
constexpr size_t WS_VDT = 204 * MiB;
constexpr size_t WS_QM = 212 * MiB;
constexpr size_t WS_KM = 224 * MiB;
constexpr size_t WS_VMT = 236 * MiB;
constexpr size_t WS_END = 244 * MiB;

struct Args { const float* in[20]; float* out; unsigned char* ws; int ph_lo, ph_hi; };

DI float bf2f(bf16_t v) { return __uint_as_float((unsigned)v << 16); }
typedef float f32x2_t __attribute__((ext_vector_type(2))); typedef __bf16 bf16x2_t __attribute__((ext_vector_type(2)));
DI unsigned pk2(float lo, float hi) { const f32x2_t v = {lo, hi}; const bf16x2_t b = __builtin_convertvector(v, bf16x2_t); return __builtin_bit_cast(unsigned, b); }
DI bf16_t f2bf(float f) { return (bf16_t)(pk2(f, 0.f) & 0xFFFFu); }
DI f32x4 mfma16(bf16x8 a, bf16x8 b, f32x4 c) { return __builtin_amdgcn_mfma_f32_16x16x32_bf16(a, b, c, 0, 0, 0); }
DI f32x16 mfma32(bf16x8 a, bf16x8 b, f32x16 c) { return __builtin_amdgcn_mfma_f32_32x32x16_bf16(a, b, c, 0, 0, 0); }
DI float wave_sum(float v) {
#pragma unroll
    for (int o = 1; o < 64; o <<= 1) v += __shfl_xor(v, o);
    return v;
}
DI int crow(int r, int hi) { return (r & 3) + 8 * (r >> 2) + 4 * hi; }
#define LDS_FENCE() asm volatile("s_waitcnt lgkmcnt(0)" ::: "memory")

DI void transpose_items(const float* __restrict__ W, int K, int N, bf16_t* __restrict__ WT, int Npad, float* scr, int gw, int ngw, int lane) {
    const int nnb = Npad / 32, items = (K / 64) * nnb;
    for (int it = gw; it < items; it += ngw) {
        const int kb = it / nnb, nb = it % nnb, k0 = kb * 64, n0 = nb * 32;
        const int n = n0 + (lane & 31);
#pragma unroll 8
        for (int i = 0; i < 32; ++i) { const int kk = 2 * i + (lane >> 5); scr[kk * 33 + (lane & 31)] = (n < N) ? W[(size_t)(k0 + kk) * N + n] : 0.f; }
        LDS_FENCE();
        const int c = lane & 7;
#pragma unroll
        for (int j = 0; j < 4; ++j) {
            const int nn = (lane >> 3) + 8 * j; const float* s = scr + (8 * c) * 33 + nn;
            u32x4 o; o[0] = pk2(s[0 * 33], s[1 * 33]); o[1] = pk2(s[2 * 33], s[3 * 33]); o[2] = pk2(s[4 * 33], s[5 * 33]); o[3] = pk2(s[6 * 33], s[7 * 33]);
            *(u32x4*)(WT + (size_t)(n0 + nn) * K + k0 + 8 * c) = o;
        }
        LDS_FENCE();
    }
}

DI void rmsnorm_rows(const float* __restrict__ x, const float* __restrict__ gain, bf16_t* __restrict__ out, int gw, int ngw, int lane) {
    for (int row = gw; row < MTOK; row += ngw) {
        const f32x4* xr = (const f32x4*)(x + (size_t)row * DM) + lane;
        f32x4 v[4]; float ss = 0.f;
#pragma unroll
        for (int j = 0; j < 4; ++j) { v[j] = xr[64 * j]; ss += (v[j][0] * v[j][0] + v[j][1] * v[j][1]) + (v[j][2] * v[j][2] + v[j][3] * v[j][3]); }
        ss = wave_sum(ss);
        const float rinv = rsqrtf(ss * (1.f / DM) + RMS_EPS);
        u32x2* o = (u32x2*)(out + (size_t)row * DM) + lane;
#pragma unroll
        for (int j = 0; j < 4; ++j) {
            const f32x4 g = ((const f32x4*)gain)[lane + 64 * j];
            u32x2 w; w[0] = pk2(v[j][0] * rinv * g[0], v[j][1] * rinv * g[1]); w[1] = pk2(v[j][2] * rinv * g[2], v[j][3] * rinv * g[3]);
            o[64 * j] = w;
        }
    }
}

DI void phase_prep(const Args& a, int layer, unsigned char* smem) {
    int tid_ = threadIdx.x; asm volatile("" : "+v"(tid_)); const int tid = tid_, lane = tid & 63, wid = tid >> 6;
    const int gw = blockIdx.x * 8 + wid, ngw = gridDim.x * 8;
    float* scr = (float*)(smem + wid * 8448);
    unsigned char* ws = a.ws;
    transpose_items(a.in[2] + (size_t)layer * DM * DIN, DM, DIN, (bf16_t*)(ws + WS_WIN), NP, scr, gw, ngw, lane);
    transpose_items(a.in[16] + (size_t)layer * DM * DM, DM, DM, (bf16_t*)(ws + WS_WOUT), DM, scr, gw, ngw, lane);
    transpose_items(a.in[18] + (size_t)layer * DM * DFF, DM, DFF, (bf16_t*)(ws + WS_WUP), DFF, scr, gw, ngw, lane);
    transpose_items(a.in[19] + (size_t)layer * DFF * DM, DFF, DM, (bf16_t*)(ws + WS_WDOWN), DM, scr, gw, ngw, lane);
    transpose_items(a.in[11] + (size_t)layer * 192 * 384, 192, 384, (bf16_t*)(ws + WS_WUQ), 384, scr, gw, ngw, lane);
    transpose_items(a.in[12] + (size_t)layer * 128 * 512, 128, 512, (bf16_t*)(ws + WS_WUKV), 512, scr, gw, ngw, lane);
    if (layer == 0) {
        float* cosT = (float*)(ws + WS_ROPE); float* sinT = cosT + SEQ * 16;
        for (int idx = blockIdx.x * 512 + tid; idx < SEQ * 16; idx += gridDim.x * 512) {
            const int t = idx >> 4, i = idx & 15;
            const float inv = powf(10000.f, -(float)i * (1.f / 16.f));
            const float ang = (float)t * inv;
            const double kq = rint((double)ang * 0.15915494309189535);
            const float rf = (float)((double)ang - kq * 6.283185307179586);
            cosT[idx] = __cosf(rf); sinT[idx] = __sinf(rf);
        }
    }
    const float* x = (layer == 0) ? a.in[0] : a.out;
    rmsnorm_rows(x, a.in[1] + layer * DM, (bf16_t*)(ws + WS_XN), gw, ngw, lane);
}

struct EpiBf16 { bf16_t* O; int ldo;
    DI void operator()(int row, int col, f32x4 v) const { u32x2 w; w[0] = pk2(v[0], v[1]); w[1] = pk2(v[2], v[3]); *(u32x2*)(O + (size_t)row * ldo + col) = w; } };
struct EpiResid { const float* R; float* O;
    DI void operator()(int row, int col, f32x4 v) const { const size_t off = (size_t)row * DM + col; const f32x4 r = *(const f32x4*)(R + off); *(f32x4*)(O + off) = r + v; } };
struct EpiRelu2 { bf16_t* O;
    DI void operator()(int row, int col, f32x4 v) const {
        float t0 = fmaxf(v[0], 0.f), t1 = fmaxf(v[1], 0.f), t2 = fmaxf(v[2], 0.f), t3 = fmaxf(v[3], 0.f);
        u32x2 w; w[0] = pk2(t0 * t0, t1 * t1); w[1] = pk2(t2 * t2, t3 * t3); *(u32x2*)(O + (size_t)row * DFF + col) = w; } };

template <class Epi>
DI void gemm_simple(const bf16_t* __restrict__ A, int lda, const bf16_t* __restrict__ Bt, int ldb, int M, int N, int K, const Epi& E) {
    int tid_ = threadIdx.x; asm volatile("" : "+v"(tid_)); const int tid = tid_, lane = tid & 63, wid = tid >> 6, wr = wid >> 2, wc = wid & 3;
    const int nN = (N + 255) / 256, nunits = (M / 128) * nN;
    const int fr = lane & 15, fq = lane >> 4;
    for (int u = blockIdx.x; u < nunits; u += gridDim.x) {
        const int pm = u / nN, pn = u % nN;
        const int m0 = pm * 128 + wr * 64, n0 = pn * 256 + wc * 64;
        if (n0 >= N) continue;
        f32x4 acc[4][4];
#pragma unroll
        for (int i = 0; i < 4; ++i)
#pragma unroll
            for (int j = 0; j < 4; ++j) acc[i][j] = (f32x4){0.f, 0.f, 0.f, 0.f};
        const bf16_t* ap = A + (size_t)(m0 + fr) * lda + fq * 8;
        const bf16_t* bp = Bt + (size_t)(n0 + fr) * ldb + fq * 8;
#pragma unroll 2
        for (int k = 0; k < K; k += 32) {
            bf16x8 af[4], bfr[4];
#pragma unroll
            for (int i = 0; i < 4; ++i) af[i] = *(const bf16x8*)(ap + (size_t)(i * 16) * lda + k);
#pragma unroll
            for (int j = 0; j < 4; ++j) bfr[j] = *(const bf16x8*)(bp + (size_t)(j * 16) * ldb + k);
#pragma unroll
            for (int i = 0; i < 4; ++i)
#pragma unroll
                for (int j = 0; j < 4; ++j) acc[i][j] = mfma16(bfr[j], af[i], acc[i][j]);
        }
#pragma unroll
        for (int i = 0; i < 4; ++i)
#pragma unroll
            for (int j = 0; j < 4; ++j) E(m0 + i * 16 + fr, n0 + j * 16 + 4 * fq, acc[i][j]);
    }
}

constexpr int TK_QLD = 392, TK_KVLD = 520, TK_Q = 0, TK_KV = 64 * TK_QLD * 2;

DI void gemm_rows64_lds(const bf16_t* __restrict__ A, int lda, const bf16_t* __restrict__ Bt, int ldb, int N, int K, bf16_t* tile, int ldt, int wid, int lane) {
    const int n0 = wid * 64; if (n0 >= N) return;
    const int fr = lane & 15, fq = lane >> 4;
    f32x4 acc[4][4];
#pragma unroll
    for (int i = 0; i < 4; ++i)
#pragma unroll
        for (int j = 0; j < 4; ++j) acc[i][j] = (f32x4){0.f, 0.f, 0.f, 0.f};
    const bf16_t* ap = A + (size_t)fr * lda + fq * 8; const bf16_t* bp = Bt + (size_t)(n0 + fr) * ldb + fq * 8;
#pragma unroll 2
    for (int k = 0; k < K; k += 32) {
        bf16x8 af[4], bfr[4];
#pragma unroll
        for (int i = 0; i < 4; ++i) af[i] = *(const bf16x8*)(ap + (size_t)(i * 16) * lda + k);
#pragma unroll
        for (int j = 0; j < 4; ++j) bfr[j] = *(const bf16x8*)(bp + (size_t)(j * 16) * ldb + k);
#pragma unroll
        for (int i = 0; i < 4; ++i)
#pragma unroll
            for (int j = 0; j < 4; ++j) acc[i][j] = mfma16(bfr[j], af[i], acc[i][j]);
    }
#pragma unroll
    for (int i = 0; i < 4; ++i)
#pragma unroll
        for (int j = 0; j < 4; ++j) { u32x2 w; w[0] = pk2(acc[i][j][0], acc[i][j][1]); w[1] = pk2(acc[i][j][2], acc[i][j][3]); *(u32x2*)(tile + (i * 16 + fr) * ldt + n0 + j * 16 + 4 * fq) = w; }
}

DI void gla1_unit(const Args& a, int layer, unsigned char* smem, int u);

DI void phase_token(const Args& a, int layer, unsigned char* smem) {
    int tid_ = threadIdx.x; asm volatile("" : "+v"(tid_)); const int tid = tid_, lane = tid & 63, wid = tid >> 6;
    bf16_t* proj = (bf16_t*)(a.ws + WS_PROJ);
    bf16_t* qm = (bf16_t*)(a.ws + WS_QM); bf16_t* km = (bf16_t*)(a.ws + WS_KM);
    bf16_t* vdT = (bf16_t*)(a.ws + WS_VDT); bf16_t* vmT = (bf16_t*)(a.ws + WS_VMT);
    const float* gq = a.in[6] + layer * 64; const float* gk = a.in[7] + layer * 64;
    const float* gcq = a.in[9] + layer * 192; const float* gckv = a.in[10] + layer * 128;
    const float* gqn = a.in[13] + layer * 96; const float* gkn = a.in[14] + layer * 96;
    const float* cosT = (const float*)(a.ws + WS_ROPE); const float* sinT = cosT + SEQ * 16;
    bf16_t* tile = (bf16_t*)smem;
    bf16_t* qraw = (bf16_t*)(smem + TK_Q); bf16_t* kvraw = (bf16_t*)(smem + TK_KV);
    for (int u = blockIdx.x; u < MTOK / 64; u += gridDim.x) {
        const int t0 = u * 64, b = t0 >> 13, tt = t0 & 8191;
        for (int i = 0; i < 8; ++i) {
            bf16_t* p = proj + (size_t)(t0 + wid * 8 + i) * NP;
#pragma unroll
            for (int h = 0; h < 4; ++h) {
                float v = bf2f(p[C_DQ + h * 64 + lane]); float ss = wave_sum(v * v); float rinv = rsqrtf(ss * (1.f / 64.f) + RMS_EPS);
                p[C_DQ + h * 64 + lane] = f2bf(v * rinv * gq[lane] * DSA_QS);
                v = bf2f(p[C_DK + h * 64 + lane]); ss = wave_sum(v * v); rinv = rsqrtf(ss * (1.f / 64.f) + RMS_EPS);
                p[C_DK + h * 64 + lane] = f2bf(v * rinv * gk[lane]);
            }
            {
                const float c0 = bf2f(p[C_MCQ + lane]), c1 = bf2f(p[C_MCQ + 64 + lane]), c2 = bf2f(p[C_MCQ + 128 + lane]);
                const float ss = wave_sum(c0 * c0 + c1 * c1 + c2 * c2); const float rinv = rsqrtf(ss * (1.f / 192.f) + RMS_EPS);
                p[C_MCQ + lane] = f2bf(c0 * rinv * gcq[lane]); p[C_MCQ + 64 + lane] = f2bf(c1 * rinv * gcq[64 + lane]); p[C_MCQ + 128 + lane] = f2bf(c2 * rinv * gcq[128 + lane]);
            }
            {
                const float c0 = bf2f(p[C_MCKV + lane]), c1 = bf2f(p[C_MCKV + 64 + lane]);
                const float ss = wave_sum(c0 * c0 + c1 * c1); const float rinv = rsqrtf(ss * (1.f / 128.f) + RMS_EPS);
                p[C_MCKV + lane] = f2bf(c0 * rinv * gckv[lane]); p[C_MCKV + 64 + lane] = f2bf(c1 * rinv * gckv[64 + lane]);
            }
        }
        _Pragma("unroll 2") for (int e = tid; e < 64 * 32; e += 512) {
            const int r = e >> 5, ch = e & 31;
            *(u32x4*)(tile + r * 264 + ch * 8) = *(const u32x4*)(proj + (size_t)(t0 + r) * NP + C_DV + ch * 8);
        }
        __syncthreads();
        _Pragma("unroll 2") for (int e = tid; e < 256 * 8; e += 512) {
            const int hd = e >> 3, ch = e & 7; u32x4 v;
#pragma unroll
            for (int j = 0; j < 4; ++j) v[j] = (unsigned)tile[(ch * 8 + 2 * j) * 264 + hd] | ((unsigned)tile[(ch * 8 + 2 * j + 1) * 264 + hd] << 16);
            *(u32x4*)(vdT + ((size_t)(b * 256 + hd)) * SEQ + tt + ch * 8) = v;
        }
        __syncthreads();
        gemm_rows64_lds(proj + (size_t)t0 * NP + C_MCQ, NP, (const bf16_t*)(a.ws + WS_WUQ), 192, 384, 192, qraw, TK_QLD, wid, lane);
        gemm_rows64_lds(proj + (size_t)t0 * NP + C_MCKV, NP, (const bf16_t*)(a.ws + WS_WUKV), 128, 512, 128, kvraw, TK_KVLD, wid, lane);
        __syncthreads();
        for (int i = 0; i < 8; ++i) {
            const int rl = wid * 8 + i, row = t0 + rl, t = row & 8191;
            const float cs = cosT[t * 16 + (lane & 15)], sn = sinT[t * 16 + (lane & 15)];
#pragma unroll
            for (int h = 0; h < 4; ++h) {
                {
                    const bf16_t* q = qraw + rl * TK_QLD + h * 96;
                    float v0 = bf2f(q[lane]); float v1 = (lane < 32) ? bf2f(q[64 + lane]) : 0.f;
                    const float ss = wave_sum(v0 * v0 + v1 * v1); const float rinv = rsqrtf(ss * (1.f / 96.f) + RMS_EPS);
                    v0 = v0 * rinv * gqn[lane]; v1 = (lane < 32) ? v1 * rinv * gqn[64 + lane] : 0.f;
                    const float pr = __shfl_xor(v1, 16);
                    const float r1 = (lane < 16) ? (v1 * cs - pr * sn) : (v1 * cs + pr * sn);
                    bf16_t* qo = qm + (size_t)row * 384 + h * 96;
                    qo[lane] = f2bf(v0 * MLA_QS); if (lane < 32) qo[64 + lane] = f2bf(r1 * MLA_QS);
                }
                {
                    float v0 = bf2f(kvraw[rl * TK_KVLD + h * 128 + lane]); float v1 = (lane < 32) ? bf2f(proj[(size_t)row * NP + C_MKR + lane]) : 0.f;
                    const float ss = wave_sum(v0 * v0 + v1 * v1); const float rinv = rsqrtf(ss * (1.f / 96.f) + RMS_EPS);
                    v0 = v0 * rinv * gkn[lane]; v1 = (lane < 32) ? v1 * rinv * gkn[64 + lane] : 0.f;
                    const float pr = __shfl_xor(v1, 16);
                    const float r1 = (lane < 16) ? (v1 * cs - pr * sn) : (v1 * cs + pr * sn);
                    bf16_t* ko = km + (size_t)row * 384 + h * 96;
                    ko[lane] = f2bf(v0); if (lane < 32) ko[64 + lane] = f2bf(r1);
                }
            }
        }
        _Pragma("unroll 2") for (int e = tid; e < 256 * 8; e += 512) {
            const int hd = e >> 3, ch = e & 7, col = (hd >> 6) * 128 + 64 + (hd & 63); u32x4 v;
#pragma unroll
            for (int j = 0; j < 4; ++j) v[j] = (unsigned)kvraw[(ch * 8 + 2 * j) * TK_KVLD + col] | ((unsigned)kvraw[(ch * 8 + 2 * j + 1) * TK_KVLD + col] << 16);
            *(u32x4*)(vmT + ((size_t)(b * 256 + hd)) * SEQ + tt + ch * 8) = v;
        }
        __syncthreads();
        for (int h = 0; h < ((PROBE_DUP & 32) ? 8 : 4); ++h) gla1_unit(a, layer, smem, ((b * 4 + (h & 3)) << 7) | (tt >> 6));
    }
}

constexpr int GL_B = 0, GL_GLR = 16384, GL_GU = 20480, GL_BIAS = 24576, GL_QDEC = 24832, GL_KINV = 34048, GL_VT = 43264, GL_SPT = 61696, GL_SC = 80128, GL_O = 89344;
DI float logsig(float z) { return fminf(z, 0.f) - log1pf(expf(-fabsf(z))); }

DI void gla_stage_b(const Args& a, int layer, unsigned char* smem, int h, size_t row0) {
    int tid_ = threadIdx.x; asm volatile("" : "+v"(tid_)); const int tid = tid_;
    const bf16_t* proj = (const bf16_t*)(a.ws + WS_PROJ);
    float* bL = (float*)(smem + GL_B); float* glr = (float*)(smem + GL_GLR); float* gu = (float*)(smem + GL_GU); float* bias = (float*)(smem + GL_BIAS);
    const float* gup = a.in[3] + (size_t)layer * 16 * 256; const float* gb = a.in[4] + layer * 256;
    _Pragma("unroll 2") for (int e = tid; e < 1024; e += 512) { const int c = e >> 4, r = e & 15; glr[e] = bf2f(proj[(row0 + c) * NP + C_GLR + r]); }
    _Pragma("unroll 2") for (int e = tid; e < 1024; e += 512) { const int r = e >> 6, d = e & 63; gu[e] = gup[r * 256 + h * 64 + d]; }
    if (tid < 64) bias[tid] = gb[h * 64 + tid];
    __syncthreads();
    _Pragma("unroll 2") for (int e = tid; e < 4096; e += 512) {
        const int c = e >> 6, d = e & 63; float z = bias[d];
#pragma unroll
        for (int r = 0; r < 16; ++r) z = fmaf(glr[c * 16 + r], gu[r * 64 + d], z);
        bL[e] = logsig(z) * (1.f / 16.f);
    }
    __syncthreads();
    if (tid < 64) { float run = 0.f; for (int c = 0; c < 64; ++c) { run += bL[c * 64 + tid]; bL[c * 64 + tid] = run; } }
    __syncthreads();
}

DI void gla1_unit(const Args& a, int layer, unsigned char* smem, int u) {
    int tid_ = threadIdx.x; asm volatile("" : "+v"(tid_)); const int tid = tid_, lane = tid & 63, wid = tid >> 6;
    const bf16_t* proj = (const bf16_t*)(a.ws + WS_PROJ);
    float* G = (float*)(a.ws + WS_GLA); float* dec = (float*)(a.ws + WS_GDEC);
    float* bL = (float*)(smem + GL_B); bf16_t* kendT = (bf16_t*)(smem + GL_KINV); bf16_t* VT = (bf16_t*)(smem + GL_VT);
    {
        const int bh = u >> 7, n = u & 127, b = bh >> 2, h = bh & 3;
        const size_t row0 = (size_t)b * SEQ + n * 64;
        gla_stage_b(a, layer, smem, h, row0);
        _Pragma("unroll 2") for (int e = tid; e < 4096; e += 512) {
            const int c = e >> 6, d = e & 63;
            const float k = bf2f(proj[(row0 + c) * NP + C_GK + h * 64 + d]);
            kendT[d * 72 + c] = f2bf(k * expf(bL[63 * 64 + d] - bL[c * 64 + d]));
        }
        _Pragma("unroll 2") for (int e = tid; e < 8192; e += 512) { const int c = e >> 7, v = e & 127; VT[v * 72 + c] = proj[(row0 + c) * NP + C_GV + h * 128 + v]; }
        if (tid < 64) dec[(size_t)u * 64 + tid] = expf(bL[63 * 64 + tid]);
        __syncthreads();
#pragma unroll
        for (int i = 0; i < 4; ++i) {
            const int tile = wid * 4 + i, tv = tile >> 2, td = tile & 3;
            f32x4 acc = {0.f, 0.f, 0.f, 0.f};
#pragma unroll
            for (int ks = 0; ks < 2; ++ks) {
                const bf16x8 av = *(const bf16x8*)(VT + (tv * 16 + (lane & 15)) * 72 + ks * 32 + 8 * (lane >> 4));
                const bf16x8 bv = *(const bf16x8*)(kendT + (td * 16 + (lane & 15)) * 72 + ks * 32 + 8 * (lane >> 4));
                acc = mfma16(av, bv, acc);
            }
#pragma unroll
            for (int r = 0; r < 4; ++r) G[((size_t)u * 128 + tv * 16 + 4 * (lane >> 4) + r) * 64 + td * 16 + (lane & 15)] = acc[r];
        }
        __syncthreads();
    }
}

DI void phase_gla2(const Args& a) {
    float* G = (float*)(a.ws + WS_GLA); const float* dec = (const float*)(a.ws + WS_GDEC);
    if (threadIdx.x < 256)
    for (int e = blockIdx.x * 256 + threadIdx.x; e < 65536; e += gridDim.x * 256) {
        const int bh = e >> 13, vd = e & 8191, d = e & 63;
        float st = 0.f;
        for (int n0 = 0; n0 < 128; n0 += 8) {
            float inc[8], dc[8];
#pragma unroll
            for (int j = 0; j < 8; ++j) { const size_t un = (size_t)bh * 128 + n0 + j; inc[j] = G[un * 8192 + vd]; dc[j] = dec[un * 64 + d]; }
#pragma unroll
            for (int j = 0; j < 8; ++j) { const size_t un = (size_t)bh * 128 + n0 + j; G[un * 8192 + vd] = st; st = fmaf(dc[j], st, inc[j]); }
        }
    }
}

DI void phase_gla3(const Args& a, int layer, unsigned char* smem) {
    int tid_ = threadIdx.x; asm volatile("" : "+v"(tid_)); const int tid = tid_, lane = tid & 63, wid = tid >> 6;
    const bf16_t* proj = (const bf16_t*)(a.ws + WS_PROJ);
    const float* G = (const float*)(a.ws + WS_GLA);
    bf16_t* mix = (bf16_t*)(a.ws + WS_XN);
    const float* gnorm = a.in[5] + layer * 512;
    float* bL = (float*)(smem + GL_B); bf16_t* qdec = (bf16_t*)(smem + GL_QDEC); bf16_t* kinv = (bf16_t*)(smem + GL_KINV); bf16_t* VT = (bf16_t*)(smem + GL_VT);
    bf16_t* SpT = (bf16_t*)(smem + GL_SPT); bf16_t* sc = (bf16_t*)(smem + GL_SC); float* oL = (float*)(smem + GL_O);
    for (int u = blockIdx.x; u < 1024; u += gridDim.x) {
        const int bh = u >> 7, n = u & 127, b = bh >> 2, h = bh & 3;
        const size_t row0 = (size_t)b * SEQ + n * 64;
        gla_stage_b(a, layer, smem, h, row0);
        _Pragma("unroll 2") for (int e = tid; e < 4096; e += 512) {
            const int c = e >> 6, d = e & 63; const float bb = bL[e];
            const float q = bf2f(proj[(row0 + c) * NP + C_GQ + h * 64 + d]), k = bf2f(proj[(row0 + c) * NP + C_GK + h * 64 + d]);
            qdec[c * 72 + d] = f2bf(q * 0.125f * expf(bb)); kinv[c * 72 + d] = f2bf(k * expf(-bb));
        }
        _Pragma("unroll 2") for (int e = tid; e < 8192; e += 512) { const int c = e >> 7, v = e & 127; VT[v * 72 + c] = proj[(row0 + c) * NP + C_GV + h * 128 + v]; }
        _Pragma("unroll 2") for (int e = tid; e < 8192; e += 512) { const int v = e >> 6, d = e & 63; SpT[v * 72 + d] = f2bf(G[(size_t)u * 8192 + e]); }
        _Pragma("unroll 2") for (int e = tid; e < 64 * 72 / 2; e += 512) ((unsigned*)sc)[e] = 0u;
        __syncthreads();
        for (int idx = wid; idx < 10; idx += 8) {
            int tc = 0, rem = idx; while (rem > tc) { rem -= tc + 1; ++tc; } const int ts = rem;
            f32x4 acc = {0.f, 0.f, 0.f, 0.f};
#pragma unroll
            for (int ks = 0; ks < 2; ++ks) {
                const bf16x8 av = *(const bf16x8*)(qdec + (tc * 16 + (lane & 15)) * 72 + ks * 32 + 8 * (lane >> 4));
                const bf16x8 bv = *(const bf16x8*)(kinv + (ts * 16 + (lane & 15)) * 72 + ks * 32 + 8 * (lane >> 4));
                acc = mfma16(av, bv, acc);
            }
            const int s = ts * 16 + (lane & 15);
#pragma unroll
            for (int r = 0; r < 4; ++r) { const int c = tc * 16 + 4 * (lane >> 4) + r; sc[c * 72 + s] = f2bf((s <= c) ? acc[r] : 0.f); }
        }
        __syncthreads();
#pragma unroll
        for (int i = 0; i < 4; ++i) {
            const int tile = wid * 4 + i, tc = tile >> 3, tv = tile & 7;
            f32x4 acc = {0.f, 0.f, 0.f, 0.f};
#pragma unroll
            for (int ks = 0; ks < 2; ++ks) {
                const bf16x8 av = *(const bf16x8*)(sc + (tc * 16 + (lane & 15)) * 72 + ks * 32 + 8 * (lane >> 4));
                const bf16x8 bv = *(const bf16x8*)(VT + (tv * 16 + (lane & 15)) * 72 + ks * 32 + 8 * (lane >> 4));
                acc = mfma16(av, bv, acc);
            }
#pragma unroll
            for (int ks = 0; ks < 2; ++ks) {
                const bf16x8 av = *(const bf16x8*)(qdec + (tc * 16 + (lane & 15)) * 72 + ks * 32 + 8 * (lane >> 4));
                const bf16x8 bv = *(const bf16x8*)(SpT + (tv * 16 + (lane & 15)) * 72 + ks * 32 + 8 * (lane >> 4));
                acc = mfma16(av, bv, acc);
            }
#pragma unroll
            for (int r = 0; r < 4; ++r) oL[(tc * 16 + 4 * (lane >> 4) + r) * 132 + tv * 16 + (lane & 15)] = acc[r];
        }
        __syncthreads();
        {
            const int c = tid >> 3, sub = tid & 7;
            float ov[16]; float ss = 0.f;
#pragma unroll
            for (int j = 0; j < 16; ++j) { ov[j] = oL[c * 132 + sub * 16 + j]; ss += ov[j] * ov[j]; }
            ss += __shfl_xor(ss, 1); ss += __shfl_xor(ss, 2); ss += __shfl_xor(ss, 4);
            const float rinv = rsqrtf(ss * (1.f / 128.f) + RMS_EPS);
            const bf16_t* gp = proj + (row0 + c) * NP + C_GG + h * 128 + sub * 16;
            bf16_t* mp = mix + (row0 + c) * DM + h * 128 + sub * 16;
            unsigned w[8];
#pragma unroll
            for (int j = 0; j < 16; j += 2) {
                const float g0 = bf2f(gp[j]), g1 = bf2f(gp[j + 1]);
                const float s0 = g0 / (1.f + expf(-g0)), s1 = g1 / (1.f + expf(-g1));
                w[j >> 1] = pk2(ov[j] * rinv * gnorm[h * 128 + sub * 16 + j] * s0, ov[j + 1] * rinv * gnorm[h * 128 + sub * 16 + j + 1] * s1);
            }
            u32x4 w0, w1; w0[0] = w[0]; w0[1] = w[1]; w0[2] = w[2]; w0[3] = w[3]; w1[0] = w[4]; w1[1] = w[5]; w1[2] = w[6]; w1[3] = w[7];
            *(u32x4*)mp = w0; *(u32x4*)(mp + 8) = w1;
        }
        __syncthreads();
    }
}

DI unsigned fkey(float s) { const unsigned u = __float_as_uint(s); return u ^ ((unsigned)((int)u >> 31) | 0x80000000u); }
DI void dsa_scores(bf16x8 ka, const bf16x8 (&bq)[9], const float (&wh)[8], float (&sc)[4]) {
    const f32x4 z = {0.f, 0.f, 0.f, 0.f};
    f32x4 acc = mfma16(ka, bq[8], z);
#pragma unroll
    for (int h = 0; h < 8; ++h) {
        const f32x4 d = mfma16(ka, bq[h], z);
#pragma unroll
        for (int r = 0; r < 4; ++r) acc[r] = __builtin_fmaf(wh[h], __builtin_fabsf(d[r]), acc[r]);
    }
#pragma unroll
    for (int r = 0; r < 4; ++r) sc[r] = acc[r] + 0.0f;
}
DI unsigned suffix_incl(unsigned v, int lane) {
#pragma unroll
    for (int off = 1; off < 64; off <<= 1) { const unsigned o = __shfl_down(v, off); if (lane + off < 64) v += o; }
    return v;
}

template <int VAR>
DI void phase_dsa_select(const Args& a, unsigned char* smem) {
    int tid_ = threadIdx.x; asm volatile("" : "+v"(tid_)); const int tid = tid_, lane = tid & 63;
    const int wid = __builtin_amdgcn_readfirstlane(tid >> 6);
    const bf16_t* proj = (const bf16_t*)(a.ws + WS_PROJ);
    unsigned* mask = (unsigned*)(a.ws + WS_MASK);
    unsigned* hist = (unsigned*)smem;
    unsigned* maskL = (unsigned*)smem; unsigned long long* cand = (unsigned long long*)(smem + 16512);
    int* sel = (int*)(smem + 131072); int* cnt = sel + 64; unsigned* csum = (unsigned*)(sel + 128);
    const int qrow = lane & 15, kq = lane >> 4; const unsigned qsw = (unsigned)qrow << 1;
    for (int uu = blockIdx.x; uu < 512; uu += gridDim.x)
    for (int half = 0; half < 2; ++half) {
        const int u = half ? 1023 - uu : uu;
        const int b = u & 1, t0 = (511 - (u >> 1)) * 16;
        const size_t g0 = (size_t)b * SEQ + t0;
        unsigned* gmask = mask + g0 * 256;
        if (t0 < 256) {
            _Pragma("unroll 2") for (int e = tid; e < 4096; e += 512) {
                const int r = e >> 8, j = e & 255, t = t0 + r; unsigned w;
                if (32 * j + 31 <= t) w = 0xFFFFFFFFu; else if (32 * j > t) w = 0u; else w = (2u << (t - 32 * j)) - 1u;
                gmask[e] = w;
            }
            continue;
        }
        const bf16_t* qp = proj + (g0 + qrow) * NP;
        bf16x8 bq[9]; float wh[8];
        {
            float qb[8];
#pragma unroll
            for (int j = 0; j < 8; ++j) qb[j] = 0.f;
#pragma unroll
            for (int h = 0; h < 8; ++h) {
                bq[h] = *(const bf16x8*)(qp + C_IQ + h * 32 + kq * 8); wh[h] = bf2f(qp[C_IW + h]) * 0.03125f;
#pragma unroll
                for (int j = 0; j < 8; ++j) qb[j] = fmaf(wh[h], bf2f((bf16_t)bq[h][j]), qb[j]);
            }
            u32x4 w4; w4[0] = pk2(qb[0], qb[1]); w4[1] = pk2(qb[2], qb[3]); w4[2] = pk2(qb[4], qb[5]); w4[3] = pk2(qb[6], qb[7]);
            bq[8] = __builtin_bit_cast(bf16x8, w4);
        }
        unsigned dummy = 0u;
        const int tq = t0 + qrow, nfull = t0 / 16;
        const bool diag_mine = (wid == (nfull & 7));
        const bf16_t* kbase = proj + ((size_t)b * SEQ + qrow) * NP + C_IK + kq * 8;
        _Pragma("unroll 2") for (int e = tid; e < 8192; e += 512) ((u32x4*)hist)[e] = (u32x4){0u, 0u, 0u, 0u};
        __syncthreads();
#define SEL_LD(kt_) (*(const bf16x8*)(kbase + (size_t)(min((kt_), nfull) * 16) * NP))
#define SEL_PA(KA, kt_) do { if ((kt_) < nfull) { float sc[4]; dsa_scores(KA, bq, wh, sc); \
            _Pragma("unroll") for (int r = 0; r < 4; ++r) { const unsigned key = fkey(sc[r]); if (VAR & 2) dummy ^= key; else if (VAR & 16) hist[qrow * 2048 + ((key >> 21) ^ qsw)] = key; else atomicAdd(&hist[qrow * 2048 + ((key >> 21) ^ qsw)], 1u << ((key >> 16) & 16u)); } } } while (0)
        bf16x8 kr0 = SEL_LD(wid), kr1 = SEL_LD(wid + 8), kr2 = SEL_LD(wid + 16), kr3 = SEL_LD(wid + 24);
        if (!(VAR & 32))
        for (int kt = wid; kt < nfull; kt += 32) {
            SEL_PA(kr0, kt);      kr0 = SEL_LD(kt + 32);
            SEL_PA(kr1, kt + 8);  kr1 = SEL_LD(kt + 40);
            SEL_PA(kr2, kt + 16); kr2 = SEL_LD(kt + 48);
            SEL_PA(kr3, kt + 24); kr3 = SEL_LD(kt + 56);
        }
        bf16x8 kan = SEL_LD(nfull);
        if (diag_mine) {
            float sc[4]; dsa_scores(kan, bq, wh, sc);
#pragma unroll
            for (int r = 0; r < 4; ++r) if (t0 + kq * 4 + r <= tq) { const unsigned key = fkey(sc[r]); atomicAdd(&hist[qrow * 2048 + ((key >> 21) ^ qsw)], 1u << ((key >> 16) & 16u)); }
        }
        __syncthreads();
        {
            const int row = tid >> 5, ch = tid & 31; const unsigned* hp = hist + row * 2048 + ch * 64; unsigned c = 0u;
#pragma unroll 8
            for (int j = 0; j < 64; ++j) { const unsigned wv = hp[(j + lane) & 63]; c += (wv & 0xFFFFu) + (wv >> 16); }
            csum[row * 32 + ch] = c;
        }
        __syncthreads();
        for (int rr = 0; rr < 2; ++rr) {
            const int row = wid * 2 + rr;
            const unsigned c = (lane < 32) ? csum[row * 32 + lane] : 0u;
            const unsigned incl = suffix_incl(c, lane), above = incl - c;
            const bool mine = (lane < 32) && (above < 256u) && (incl >= 256u);
            const unsigned long long bal = __ballot(mine);
            const int ci = bal ? (__ffsll((long long)bal) - 1) : 0;
            const unsigned aboveC = __shfl(above, ci);
            const unsigned wv = hist[row * 2048 + ci * 64 + (lane ^ (row << 1))]; const unsigned lo = wv & 0xFFFFu, hb = wv >> 16, cw = lo + hb;
            const unsigned incl2 = suffix_incl(cw, lane), above2 = aboveC + incl2 - cw;
            if (above2 < 256u && above2 + cw >= 256u) {
                const int widx = ci * 64 + lane;
                if (above2 + hb >= 256u) { sel[row * 2] = 2 * widx + 1; sel[row * 2 + 1] = (int)above2; }
                else { sel[row * 2] = 2 * widx; sel[row * 2 + 1] = (int)(above2 + hb); }
            }
        }
        __syncthreads();
        const int bst_l = sel[qrow * 2];
        __syncthreads();
        _Pragma("unroll 2") for (int e = tid; e < 1028; e += 512) ((u32x4*)maskL)[e] = (u32x4){0u, 0u, 0u, 0u};
        if (tid < 16) cnt[tid] = 0;
        __syncthreads();
#define SEL_PB(KA, kt_) do { if ((kt_) < nfull) { float sc[4]; dsa_scores(KA, bq, wh, sc); unsigned bits = 0u; \
            _Pragma("unroll") for (int r = 0; r < 4; ++r) { const unsigned key = fkey(sc[r]); const int bin = (int)(key >> 20); \
                if (bin > bst_l) bits |= 1u << r; \
                else if (bin == bst_l) { const int pos = atomicAdd(&cnt[qrow], 1); if (pos < CAND_CAP) cand[qrow * CAND_CAP + pos] = ((unsigned long long)key << 32) | (unsigned long long)(0xFFFFFFFFu - (unsigned)((kt_) * 16 + kq * 4 + r)); } } \
            if (bits) atomicOr(&maskL[qrow * 257 + ((kt_) >> 1)], bits << (((kt_) & 1) * 16 + kq * 4)); } } while (0)
        kr0 = SEL_LD(wid); kr1 = SEL_LD(wid + 8); kr2 = SEL_LD(wid + 16); kr3 = SEL_LD(wid + 24);
        if (!(VAR & 4))
        for (int kt = wid; kt < nfull; kt += 32) {
            SEL_PB(kr0, kt);      kr0 = SEL_LD(kt + 32);
            SEL_PB(kr1, kt + 8);  kr1 = SEL_LD(kt + 40);
            SEL_PB(kr2, kt + 16); kr2 = SEL_LD(kt + 48);
            SEL_PB(kr3, kt + 24); kr3 = SEL_LD(kt + 56);
        }
        kan = SEL_LD(nfull);
        if (diag_mine) {
            const int kt = nfull;
            float sc[4]; dsa_scores(kan, bq, wh, sc);
            unsigned bits = 0u;
#pragma unroll
            for (int r = 0; r < 4; ++r) {
                const int kp = kt * 16 + kq * 4 + r;
                if (kp <= tq) {
                    const unsigned key = fkey(sc[r]); const int bin = (int)(key >> 20);
                    if (bin > bst_l) bits |= 1u << r;
                    else if (bin == bst_l) { const int pos = atomicAdd(&cnt[qrow], 1); if (pos < CAND_CAP) cand[qrow * CAND_CAP + pos] = ((unsigned long long)key << 32) | (unsigned long long)(0xFFFFFFFFu - (unsigned)kp); }
                }
            }
            if (bits) atomicOr(&maskL[qrow * 257 + (kt >> 1)], bits << ((kt & 1) * 16 + kq * 4));
        }
        __syncthreads();
        if (!(VAR & 8))
        for (int rr = 0; rr < 2; ++rr) {
            const int row = wid * 2 + rr; const int n = min(cnt[row], CAND_CAP); const int need = 256 - sel[row * 2 + 1];
            const unsigned long long* cr = cand + row * CAND_CAP;
            const int nch = (n + 63) >> 6;
            unsigned long long pref = ((unsigned long long)(unsigned)sel[row * 2] << 52) | 0xFFFFE000ull;
            if (nch <= 4) {
                unsigned long long cv[4];
#pragma unroll
                for (int c = 0; c < 4; ++c) cv[c] = (c * 64 + lane < n) ? cr[c * 64 + lane] : 0ull;
                for (int bit = 51; bit >= 0; --bit) {
                    if (bit == 31) bit = 12;
                    const unsigned long long trial = pref | (1ull << bit); int c_ge = 0;
#pragma unroll
                    for (int c = 0; c < 4; ++c) c_ge += __popcll(__ballot(cv[c] >= trial));
                    if (c_ge >= need) pref = trial;
                }
#pragma unroll
                for (int c = 0; c < 4; ++c) if (cv[c] >= pref && c * 64 + lane < n) { const unsigned kp = 0xFFFFFFFFu - (unsigned)(cv[c] & 0xFFFFFFFFull); atomicOr(&maskL[row * 257 + (kp >> 5)], 1u << (kp & 31)); }
            } else {
                for (int bit = 51; bit >= 0; --bit) {
                    if (bit == 31) bit = 12;
                    const unsigned long long trial = pref | (1ull << bit); int c_ge = 0;
                    for (int c = 0; c < nch; ++c) { const unsigned long long v = (c * 64 + lane < n) ? cr[c * 64 + lane] : 0ull; c_ge += __popcll(__ballot(v >= trial)); }
                    if (c_ge >= need) pref = trial;
                }
                for (int c = 0; c < nch; ++c) if (c * 64 + lane < n) { const unsigned long long v = cr[c * 64 + lane];
                    if (v >= pref) { const unsigned kp = 0xFFFFFFFFu - (unsigned)(v & 0xFFFFFFFFull); atomicOr(&maskL[row * 257 + (kp >> 5)], 1u << (kp & 31)); } }
            }
        }
        __syncthreads();
        if (VAR & 2) { if (dummy == 0x12345u) hist[tid] = dummy; }
        if (!(VAR & 1)) _Pragma("unroll 2") for (int e = tid; e < 4096; e += 512) gmask[e] = maskL[(e >> 8) * 257 + (e & 255)];
        __syncthreads();
    }
}

DI unsigned causal_bits(int lim) { return lim >= 31 ? 0xFFFFFFFFu : (lim < 0 ? 0u : ((2u << lim) - 1u)); }

template <int DQ, bool USE_MASK>
DI void attn_block(const bf16_t* __restrict__ Q, int ldq, int qcol, const bf16_t* __restrict__ K, int ldk, int kcol, const bf16_t* __restrict__ VTb,
                   const unsigned* __restrict__ mask, int b, int qb, bf16_t* __restrict__ mix, int mixcol, const float* __restrict__ gain, unsigned char* smem) {
    constexpr int NS = DQ / 16, KS = DQ * 2 + 16, KBUF = 64 * KS, VS = 136, VBUF = 64 * VS, BUF = KBUF + VBUF, KCH = DQ / 8, NKC = 64 * KCH;
    int tid_ = threadIdx.x; asm volatile("" : "+v"(tid_)); const int tid = tid_, lane = tid & 63, r32 = lane & 31, hi = lane >> 5;
    const int wid = __builtin_amdgcn_readfirstlane(tid >> 6);
    const size_t rb = (size_t)b * SEQ; const int q0w = qb * 256 + wid * 32;
    bf16x8 qf[NS];
#pragma unroll
    for (int s = 0; s < NS; ++s) qf[s] = *(const bf16x8*)(Q + (rb + q0w + r32) * ldq + qcol + 16 * s + 8 * hi);
    const int key0 = tid / KCH, ch0 = tid % KCH;
    const bf16_t* gk0 = K + (rb + key0) * ldk + kcol + ch0 * 8; const int lk0 = key0 * KS + ch0 * 16;
    const bool has1 = (NKC > 512) && (tid + 512 < NKC);
    const int key1 = (tid + 512) / KCH, ch1 = (tid + 512) % KCH;
    const bf16_t* gk1 = K + (rb + (has1 ? key1 : 0)) * ldk + kcol + ch1 * 8; const int lk1 = key1 * KS + ch1 * 16;
    const int vd = tid >> 3, vch = tid & 7;
    const bf16_t* gv = VTb + (size_t)vd * SEQ + vch * 8; const int lv = KBUF + vd * VS + vch * 16;
    const int nt = 4 * (qb + 1), ktmax = 4 * qb + (wid >> 1);
    const unsigned* mrow = mask + (rb + q0w + r32) * 256;
    f32x16 o0, o1;
#pragma unroll
    for (int r = 0; r < 16; ++r) { o0[r] = 0.f; o1[r] = 0.f; }
    float m = -1e30f, l = 0.f;
    u32x4 kr0, kr1, vr; unsigned cm0 = 0u, cm1 = 0u, nm0 = 0u, nm1 = 0u;
    kr0 = *(const u32x4*)gk0; kr1 = kr0; if (has1) kr1 = *(const u32x4*)gk1; vr = *(const u32x4*)gv;
    if (USE_MASK) { cm0 = mrow[0]; cm1 = mrow[1]; }
    *(u32x4*)(smem + lk0) = kr0; if (has1) *(u32x4*)(smem + lk1) = kr1;
    { u32x2 a0, a1; a0[0] = vr[0]; a0[1] = vr[1]; a1[0] = vr[2]; a1[1] = vr[3]; *(u32x2*)(smem + lv) = a0; *(u32x2*)(smem + lv + 8) = a1; }
    __syncthreads();
    for (int kt = 0; kt < nt; ++kt) {
        const int cur = (kt & 1) * BUF, nxt = BUF - cur;
        const bool more = kt + 1 < nt;
        if (more) {
            kr0 = *(const u32x4*)(gk0 + (size_t)(kt + 1) * 64 * ldk); if (has1) kr1 = *(const u32x4*)(gk1 + (size_t)(kt + 1) * 64 * ldk);
            vr = *(const u32x4*)(gv + (kt + 1) * 64);
            if (USE_MASK) { nm0 = mrow[2 * kt + 2]; nm1 = mrow[2 * kt + 3]; }
        }
        if (kt <= ktmax) {
            const unsigned char* kb = smem + cur + r32 * KS + 16 * hi;
            f32x16 p0, p1;
#pragma unroll
            for (int r = 0; r < 16; ++r) { p0[r] = 0.f; p1[r] = 0.f; }
#pragma unroll
            for (int s = 0; s < NS; ++s) {
                const bf16x8 k0f = *(const bf16x8*)(kb + 32 * s); const bf16x8 k1f = *(const bf16x8*)(kb + 32 * KS + 32 * s);
                p0 = mfma32(k0f, qf[s], p0); p1 = mfma32(k1f, qf[s], p1);
            }
            unsigned vb0, vb1;
            if (USE_MASK) { vb0 = cm0; vb1 = cm1; }
            else { const int d = q0w - kt * 64 + r32; vb0 = causal_bits(d); vb1 = causal_bits(d - 32); }
            float pm = -1e30f;
#pragma unroll
            for (int r = 0; r < 16; ++r) {
                const bool v0 = (vb0 >> crow(r, hi)) & 1u, v1 = (vb1 >> crow(r, hi)) & 1u;
                pm = fmaxf(pm, v0 ? p0[r] : -1e30f); pm = fmaxf(pm, v1 ? p1[r] : -1e30f);
            }
            pm = fmaxf(pm, __shfl_xor(pm, 32));
            const float mn = fmaxf(m, pm); const float alpha = __builtin_amdgcn_exp2f(m - mn); m = mn;
            float ls = 0.f;
#pragma unroll
            for (int r = 0; r < 16; ++r) {
                const bool v0 = (vb0 >> crow(r, hi)) & 1u, v1 = (vb1 >> crow(r, hi)) & 1u;
                const float e0 = v0 ? __builtin_amdgcn_exp2f(p0[r] - mn) : 0.f, e1 = v1 ? __builtin_amdgcn_exp2f(p1[r] - mn) : 0.f;
                p0[r] = e0; p1[r] = e1; ls += e0 + e1;
            }
            l = l * alpha + ls;
            if (!__all(alpha == 1.f)) {
#pragma unroll
                for (int r = 0; r < 16; ++r) { o0[r] *= alpha; o1[r] *= alpha; }
            }
            const unsigned char* vbp = smem + cur + KBUF + r32 * VS + 8 * hi;
#pragma unroll
            for (int s4 = 0; s4 < 4; ++s4) {
                u32x4 w;
                if (s4 < 2) { const int o = 8 * s4; w[0] = pk2(p0[o], p0[o + 1]); w[1] = pk2(p0[o + 2], p0[o + 3]); w[2] = pk2(p0[o + 4], p0[o + 5]); w[3] = pk2(p0[o + 6], p0[o + 7]); }
                else { const int o = 8 * (s4 - 2); w[0] = pk2(p1[o], p1[o + 1]); w[1] = pk2(p1[o + 2], p1[o + 3]); w[2] = pk2(p1[o + 4], p1[o + 5]); w[3] = pk2(p1[o + 6], p1[o + 7]); }
                const bf16x8 pk = __builtin_bit_cast(bf16x8, w);
                const u32x2 a0 = *(const u32x2*)(vbp + 32 * s4), a1 = *(const u32x2*)(vbp + 32 * s4 + 16);
                const u32x2 c0 = *(const u32x2*)(vbp + 32 * VS + 32 * s4), c1 = *(const u32x2*)(vbp + 32 * VS + 32 * s4 + 16);
                u32x4 f0, f1; f0[0] = a0[0]; f0[1] = a0[1]; f0[2] = a1[0]; f0[3] = a1[1]; f1[0] = c0[0]; f1[1] = c0[1]; f1[2] = c1[0]; f1[3] = c1[1];
                o0 = mfma32(__builtin_bit_cast(bf16x8, f0), pk, o0);
                o1 = mfma32(__builtin_bit_cast(bf16x8, f1), pk, o1);
            }
        }
        if (more) {
            *(u32x4*)(smem + nxt + lk0) = kr0; if (has1) *(u32x4*)(smem + nxt + lk1) = kr1;
            u32x2 a0, a1; a0[0] = vr[0]; a0[1] = vr[1]; a1[0] = vr[2]; a1[1] = vr[3]; *(u32x2*)(smem + nxt + lv) = a0; *(u32x2*)(smem + nxt + lv + 8) = a1;
        }
        if (USE_MASK) { cm0 = nm0; cm1 = nm1; }
        __syncthreads();
    }
    l += __shfl_xor(l, 32);
    const float linv = 1.f / l;
    float ss = 0.f;
#pragma unroll
    for (int r = 0; r < 16; ++r) { o0[r] *= linv; o1[r] *= linv; ss += o0[r] * o0[r] + o1[r] * o1[r]; }
    ss += __shfl_xor(ss, 32);
    const float rinv = rsqrtf(ss * (1.f / 64.f) + RMS_EPS);
    bf16_t* mp = mix + (rb + q0w + r32) * DM + mixcol;
#pragma unroll
    for (int g = 0; g < 4; ++g) {
        const int d0 = 8 * g + 4 * hi;
        u32x2 w;
        w[0] = pk2(o0[4 * g] * rinv * gain[d0], o0[4 * g + 1] * rinv * gain[d0 + 1]); w[1] = pk2(o0[4 * g + 2] * rinv * gain[d0 + 2], o0[4 * g + 3] * rinv * gain[d0 + 3]);
        *(u32x2*)(mp + d0) = w;
        w[0] = pk2(o1[4 * g] * rinv * gain[32 + d0], o1[4 * g + 1] * rinv * gain[32 + d0 + 1]); w[1] = pk2(o1[4 * g + 2] * rinv * gain[32 + d0 + 2], o1[4 * g + 3] * rinv * gain[32 + d0 + 3]);
        *(u32x2*)(mp + 32 + d0) = w;
    }
}

DI void phase_attn(const Args& a, int layer, unsigned char* smem) {
    const bf16_t* qm = (const bf16_t*)(a.ws + WS_QM); const bf16_t* km = (const bf16_t*)(a.ws + WS_KM); const bf16_t* vmT = (const bf16_t*)(a.ws + WS_VMT);
    const bf16_t* proj = (const bf16_t*)(a.ws + WS_PROJ); const bf16_t* vdT = (const bf16_t*)(a.ws + WS_VDT);
    const unsigned* mask = (const unsigned*)(a.ws + WS_MASK);
    bf16_t* mix = (bf16_t*)(a.ws + WS_XN);
    for (int u = blockIdx.x; u < 256; u += gridDim.x) {
        const int bh = u & 7, b = bh >> 2, h = bh & 3, qb = u >> 3;
        attn_block<96, false>(qm, 384, h * 96, km, 384, h * 96, vmT + (size_t)(bh * 64) * SEQ, mask, b, qb, mix, 768 + h * 64, a.in[15] + layer * 256 + h * 64, smem);
        attn_block<64, true>(proj, NP, C_DQ + h * 64, proj, NP, C_DK + h * 64, vdT + (size_t)(bh * 64) * SEQ, mask, b, 31 - qb, mix, 512 + h * 64, a.in[8] + layer * 256 + h * 64, smem);
    }
}

namespace pg8 {
#define PG8_LAS __attribute__((address_space(3)))
typedef unsigned short bf16_t;
typedef short bf16x8 __attribute__((ext_vector_type(8)));
typedef float f32x4 __attribute__((ext_vector_type(4)));
typedef unsigned u32x4 __attribute__((ext_vector_type(4)));
constexpr int BM = 256, BK = 64, HALF = 128, HTB = HALF * BK * 2  , STAGE_BYTES = 8 * HTB, NXCD = 8, WGM = 8;

__host__ __device__ __forceinline__ int lds_byte(int r, int c) { const int st = (r >> 4) * 2 + (c >> 5), rr = r & 15, cc = c & 31, ob = rr * 64 + cc * 2; return st * 1024 + (ob ^ (((ob >> 9) & 1) << 5)); }
__host__ __device__ __forceinline__ void stage_rc(int b, int& R, int& C) { const int st = b / 1024, sb = b % 1024, swz = sb ^ (((sb >> 9) & 1) << 5); R = (st >> 1) * 16 + swz / 64; C = (st & 1) * 32 + (swz % 64) / 2; }
__host__ __device__ __forceinline__ int perm32(int rho) { const int n = rho >> 4, i = rho & 15; return 8 * (i >> 2) + 4 * n + (i & 3); }

struct Unit { int pm, pn; };
struct Gemm { const bf16_t* A; const bf16_t* Bt; int M, N, K; };

struct StaticOrder {
    int nM, nN, nwg, G, c;
    __host__ __device__ void init(int M, int N, int G_, int c_) { nM = M / BM; nN = N / BM; nwg = nM * nN; G = G_; c = c_; }
    __host__ __device__ bool next(int i, Unit& u) const {
        const long L = (long)i * G + c; if (L >= nwg) return false;
        int wgid = (int)L; { const int q = nwg / NXCD, r = nwg % NXCD, xcd = wgid % NXCD, off = wgid / NXCD; wgid = (xcd < r ? xcd * (q + 1) : r * (q + 1) + (xcd - r) * q) + off; }
        const int nig = WGM * nN, gid = wgid / nig, fm = gid * WGM, gsz = (nM - fm) < WGM ? (nM - fm) : WGM;
        u.pm = fm + ((wgid % nig) % gsz); u.pn = (wgid % nig) / gsz; return true;
    }
    __device__ __forceinline__ void a_ready(const Unit&) const {}
    __device__ __forceinline__ void done(const Unit&) const {}
};
__device__ __forceinline__ unsigned cvt_pk_bf16(float lo, float hi) { unsigned r; asm volatile("v_cvt_pk_bf16_f32 %0, %1, %2" : "=v"(r) : "v"(lo), "v"(hi)); return r; }
typedef float f32x2 __attribute__((ext_vector_type(2)));

template <int ACT  > struct EpiBf16 {
    static constexpr bool PERM = true, AFTER_DRAIN = false;
    bf16_t* O; int ldc;
    __device__ __forceinline__ void operator()(const f32x4 (&acc)[2][2][4][2], const Unit& u, int wr, int wc, int fr, int fq) const {
        const int row0 = u.pm * BM + wr * 64 + fr; const int col0 = u.pn * BM + wc * 32 + 8 * fq;
#pragma unroll
        for (int ai = 0; ai < 2; ++ai)
#pragma unroll
            for (int m = 0; m < 4; ++m) { bf16_t* rowp = O + (size_t)(row0 + ai * HALF + m * 16) * ldc + col0;
#pragma unroll
                for (int bj = 0; bj < 2; ++bj) { f32x4 v0 = acc[ai][bj][m][0], v1 = acc[ai][bj][m][1];
                    if (ACT == 2) {
#pragma unroll
                        for (int e = 0; e < 4; ++e) { const float a0 = fmaxf(v0[e], 0.f), a1 = fmaxf(v1[e], 0.f); v0[e] = a0 * a0; v1[e] = a1 * a1; } }
                    u32x4 w; w.x = cvt_pk_bf16(v0[0], v0[1]); w.y = cvt_pk_bf16(v0[2], v0[3]); w.z = cvt_pk_bf16(v1[0], v1[1]); w.w = cvt_pk_bf16(v1[2], v1[3]);
                    *(u32x4*)(rowp + bj * HALF) = w; } }
    }
};
struct EpiResid {
    static constexpr bool PERM = false, AFTER_DRAIN = false;
    const float* R; float* out; int ldc;
    __device__ __forceinline__ void operator()(const f32x4 (&acc)[2][2][4][2], const Unit& u, int wr, int wc, int fr, int fq) const {
        const int col0 = u.pn * BM + wc * 32 + 4 * fq;
#pragma unroll
        for (int ai = 0; ai < 2; ++ai)
#pragma unroll
            for (int m = 0; m < 4; ++m) { const size_t off = (size_t)(u.pm * BM + ai * HALF + wr * 64 + m * 16 + fr) * ldc + col0;
#pragma unroll
                for (int bj = 0; bj < 2; ++bj)
#pragma unroll
                    for (int n = 0; n < 2; ++n) { const f32x4 r = *(const f32x4*)(R + off + bj * HALF + n * 16); *(f32x4*)(out + off + bj * HALF + n * 16) = r + acc[ai][bj][m][n]; }
                asm volatile("" ::: "memory"); }
    }
};

template <class Epi, class Sched, bool ALIGN_EPI = false, bool SP2 = false>
__device__ __forceinline__ void gemm_phase(PG8_LAS unsigned char* lds, const Gemm g, const Sched& S, const Epi& E) {
    const int tid = threadIdx.x, wid = __builtin_amdgcn_readfirstlane(tid >> 6), lane = tid & 63, wr = wid >> 2, wc = wid & 3, fr = lane & 15, fq = lane >> 4;
    const int K = g.K, nt = K / BK;
    unsigned voffA[2], voffB[2];
#pragma unroll
    for (int i = 0; i < 2; ++i) { int R, C; stage_rc(tid * 16 + i * 8192, R, C); const int Rb = Epi::PERM ? ((R & ~31) + perm32(R & 31)) : R;
        voffA[i] = (unsigned)(R * K + C) * 2u; voffB[i] = (unsigned)(Rb * K + C) * 2u; }
    const size_t kstep = (size_t)(BK * 2);
    const size_t hstep = (size_t)HALF * K * 2;
    const size_t tstep = 2 * hstep;
    const unsigned ldsw = (unsigned)wid * 1024u;
    const int aoff = lds_byte(wr * 64 + fr, fq * 8), boff = lds_byte(wc * 32 + fr, fq * 8);
#define PG8_SA(b, h) (((b) * 2 + (h)) * HTB)
#define PG8_SB(b, h) ((4 + (b) * 2 + (h)) * HTB)
#define PG8_STAGE(bufoff, gbase, voff) do { _Pragma("unroll") for (int _i = 0; _i < 2; ++_i) \
        __builtin_amdgcn_global_load_lds((const unsigned*)((const char*)(gbase) + (voff)[_i]), (PG8_LAS unsigned*)(lds + (bufoff) + ldsw + _i * 8192), 16, 0, 0); } while (0)
#define PG8_LDA(dst, b, h) do { _Pragma("unroll") for (int m = 0; m < 4; ++m) _Pragma("unroll") for (int k = 0; k < 2; ++k) dst[m][k] = *(const PG8_LAS bf16x8*)(lds + PG8_SA(b, h) + aoff + m * 2048 + k * 1024); } while (0)
#define PG8_LDB(dst, b, h) do { _Pragma("unroll") for (int n = 0; n < 2; ++n) _Pragma("unroll") for (int k = 0; k < 2; ++k) dst[n][k] = *(const PG8_LAS bf16x8*)(lds + PG8_SB(b, h) + boff + n * 2048 + k * 1024); } while (0)
#define PG8_MMA(ai, bj, At, Bt) do { __builtin_amdgcn_s_setprio(1); _Pragma("unroll") for (int m = 0; m < 4; ++m) _Pragma("unroll") for (int n = 0; n < 2; ++n) _Pragma("unroll") for (int k = 0; k < 2; ++k) \
        acc[ai][bj][m][n] = __builtin_amdgcn_mfma_f32_16x16x32_bf16(Bt[n][k], At[m][k], acc[ai][bj][m][n], 0, 0, 0); __builtin_amdgcn_s_setprio(0); } while (0)
#define PG8_WAIT_V(n) asm volatile("s_waitcnt vmcnt(" #n ")" ::: "memory")
#define PG8_WAIT_L(n) asm volatile("s_waitcnt lgkmcnt(" #n ")" ::: "memory")
#define PG8_BAR __builtin_amdgcn_s_barrier()
#define PG8_SCHED __builtin_amdgcn_sched_barrier(0)
    Unit cur, nxt; int ui = 0;
    if (!S.next(0, cur)) return;
    f32x4 acc[2][2][4][2];
#pragma unroll
    for (int a = 0; a < 2; ++a)
#pragma unroll
        for (int b = 0; b < 2; ++b)
#pragma unroll
            for (int m = 0; m < 4; ++m)
#pragma unroll
                for (int n = 0; n < 2; ++n) acc[a][b][m][n] = (f32x4){0.f, 0.f, 0.f, 0.f};
    bf16x8 At[4][2], B0[2][2], B1[2][2];
    const char* cA = (const char*)g.A + (size_t)cur.pm * tstep; const char* cB = (const char*)g.Bt + (size_t)cur.pn * tstep;
    S.a_ready(cur);
    if constexpr (SP2) {
        PG8_STAGE(PG8_SB(0, 0), cB, voffB); PG8_STAGE(PG8_SB(0, 1), cB + hstep, voffB); PG8_STAGE(PG8_SA(0, 0), cA, voffA); PG8_STAGE(PG8_SA(0, 1), cA + hstep, voffA);
        if (wr == 1) PG8_BAR;
        PG8_WAIT_V(2); PG8_BAR;
        PG8_STAGE(PG8_SB(1, 0), cB + kstep, voffB); PG8_STAGE(PG8_SA(1, 0), cA + kstep, voffA); PG8_STAGE(PG8_SB(1, 1), cB + hstep + kstep, voffB);
        PG8_WAIT_V(6); PG8_BAR;
    } else {
        PG8_STAGE(PG8_SB(0, 0), cB, voffB); PG8_STAGE(PG8_SA(0, 0), cA, voffA); PG8_STAGE(PG8_SB(0, 1), cB + hstep, voffB); PG8_STAGE(PG8_SA(0, 1), cA + hstep, voffA);
        if (wr == 1) PG8_BAR;
        PG8_WAIT_V(4); PG8_BAR;
        PG8_STAGE(PG8_SB(1, 0), cB + kstep, voffB); PG8_STAGE(PG8_SA(1, 0), cA + kstep, voffA); PG8_STAGE(PG8_SB(1, 1), cB + hstep + kstep, voffB);
        PG8_WAIT_V(6); PG8_BAR;
    }
    for (;;) {
        const bool has_next = S.next(ui + 1, nxt);
        const char* nA = has_next ? (const char*)g.A + (size_t)nxt.pm * tstep : cA; const char* nB = has_next ? (const char*)g.Bt + (size_t)nxt.pn * tstep : cB;
        for (int t = 0; t < nt; t += 2) {
            const bool last = (t == nt - 2);
            const char* a1 = cA + (size_t)(t + 1) * kstep;
            const char* a2 = last ? nA : cA + (size_t)(t + 2) * kstep; const char* b2 = last ? nB : cB + (size_t)(t + 2) * kstep;
            const char* a3 = a2 + kstep; const char* b3 = b2 + kstep;
            if (last && has_next) S.a_ready(nxt);
            if constexpr (SP2) {
            PG8_LDB(B0, 0, 0); PG8_LDB(B1, 0, 1); PG8_SCHED; PG8_LDA(At, 0, 0); PG8_STAGE(PG8_SA(1, 1), a1 + hstep, voffA);
            PG8_WAIT_V(8); PG8_WAIT_L(0); PG8_BAR; PG8_MMA(0, 0, At, B0); PG8_MMA(0, 1, At, B1); PG8_BAR; PG8_SCHED;
            PG8_LDA(At, 0, 1); PG8_STAGE(PG8_SB(0, 0), b2, voffB); PG8_STAGE(PG8_SB(0, 1), b2 + hstep, voffB); PG8_STAGE(PG8_SA(0, 0), a2, voffA);
            PG8_WAIT_V(8); PG8_WAIT_L(0); PG8_BAR; PG8_MMA(1, 0, At, B0); PG8_MMA(1, 1, At, B1); PG8_BAR; PG8_SCHED;
            PG8_LDB(B0, 1, 0); PG8_LDB(B1, 1, 1); PG8_SCHED; PG8_LDA(At, 1, 0); PG8_STAGE(PG8_SA(0, 1), a2 + hstep, voffA);
            PG8_WAIT_V(8); PG8_WAIT_L(0); PG8_BAR; PG8_MMA(0, 0, At, B0); PG8_MMA(0, 1, At, B1); PG8_BAR; PG8_SCHED;
            PG8_LDA(At, 1, 1); PG8_STAGE(PG8_SB(1, 0), b3, voffB); PG8_STAGE(PG8_SB(1, 1), b3 + hstep, voffB); PG8_STAGE(PG8_SA(1, 0), a3, voffA);
            PG8_WAIT_V(8); PG8_WAIT_L(0); PG8_BAR; PG8_MMA(1, 0, At, B0); PG8_MMA(1, 1, At, B1); PG8_BAR; PG8_SCHED;
            } else {
            PG8_LDB(B0, 0, 0); PG8_SCHED; PG8_LDA(At, 0, 0); PG8_STAGE(PG8_SA(1, 1), a1 + hstep, voffA);
            PG8_WAIT_L(8); PG8_BAR; PG8_WAIT_L(0); PG8_MMA(0, 0, At, B0); PG8_BAR; PG8_SCHED;
            PG8_LDB(B1, 0, 1); PG8_STAGE(PG8_SB(0, 0), b2, voffB);
            PG8_BAR; PG8_WAIT_L(0); PG8_MMA(0, 1, At, B1); PG8_BAR;
            PG8_LDA(At, 0, 1); PG8_STAGE(PG8_SA(0, 0), a2, voffA);
            PG8_BAR; PG8_WAIT_L(0); PG8_MMA(1, 0, At, B0); PG8_BAR; PG8_SCHED;
            PG8_STAGE(PG8_SB(0, 1), b2 + hstep, voffB);
            PG8_WAIT_V(6); PG8_BAR; PG8_MMA(1, 1, At, B1); PG8_BAR;
            PG8_LDB(B0, 1, 0); PG8_SCHED; PG8_LDA(At, 1, 0); PG8_STAGE(PG8_SA(0, 1), a2 + hstep, voffA);
            PG8_WAIT_L(8); PG8_BAR; PG8_WAIT_L(0); PG8_MMA(0, 0, At, B0); PG8_BAR; PG8_SCHED;
            PG8_LDB(B1, 1, 1); PG8_STAGE(PG8_SB(1, 0), b3, voffB);
            PG8_BAR; PG8_WAIT_L(0); PG8_MMA(0, 1, At, B1); PG8_BAR;
            PG8_LDA(At, 1, 1); PG8_STAGE(PG8_SA(1, 0), a3, voffA);
            PG8_BAR; PG8_WAIT_L(0); PG8_MMA(1, 0, At, B0); PG8_BAR; PG8_SCHED;
            PG8_STAGE(PG8_SB(1, 1), b3 + hstep, voffB);
            PG8_WAIT_V(6); PG8_BAR; PG8_MMA(1, 1, At, B1); PG8_BAR;
            }
        }
        if constexpr (ALIGN_EPI) { if (wr == 0) PG8_BAR; }
        if constexpr (!Epi::AFTER_DRAIN) { E(acc, cur, wr, wc, fr, fq); S.done(cur); }
        if (!has_next) break;
#pragma unroll
        for (int a = 0; a < 2; ++a)
#pragma unroll
            for (int b = 0; b < 2; ++b)
#pragma unroll
                for (int m = 0; m < 4; ++m)
#pragma unroll
                    for (int n = 0; n < 2; ++n) acc[a][b][m][n] = (f32x4){0.f, 0.f, 0.f, 0.f};
        cur = nxt; cA = nA; cB = nB; ++ui;
        if constexpr (ALIGN_EPI) { if (wr == 1) PG8_BAR; }
    }
    PG8_WAIT_V(0);
    if constexpr (!ALIGN_EPI) { if (wr == 0) PG8_BAR; }
    PG8_BAR;
    if constexpr (Epi::AFTER_DRAIN) { E.fused(acc, cur, wr, wc, fr, fq, lds, wid, lane); S.done(cur); }
#undef PG8_SA
#undef PG8_SB
#undef PG8_STAGE
#undef PG8_LDA
#undef PG8_LDB
#undef PG8_MMA
#undef PG8_WAIT_V
#undef PG8_WAIT_L
#undef PG8_BAR
#undef PG8_SCHED
}
}

#define LAS __attribute__((address_space(3)))
#define XB_TMO      128
#define XB_XCNT(j)  (256  + 64 * (j))
#define XB_XSUB(j)  (1280 + 64 * (j))
#define XB_XGEN(j)  (2304 + 64 * (j))
#define XB_TOP      3328
#define XB_TOPGEN   3392
#define XCD_BAR_WORDS 3456
#define XB_SPIN_CAP (1u << 18)

__device__ __forceinline__ unsigned xb_ld(unsigned* p)              { return __hip_atomic_load(p, __ATOMIC_RELAXED, __HIP_MEMORY_SCOPE_AGENT); }
__device__ __forceinline__ unsigned xb_add(unsigned* p, unsigned v) { return __hip_atomic_fetch_add(p, v, __ATOMIC_RELAXED, __HIP_MEMORY_SCOPE_AGENT); }
__device__ __forceinline__ unsigned xb_xcc_id() { return (unsigned)__builtin_amdgcn_s_getreg((3 << 11) | 20) & 0xFu; }
#define XB_SPIN(cond, bar) do { unsigned _sp = 0; while (cond) { __builtin_amdgcn_s_sleep(1); \
    if ((++_sp & 255u) == 0u) { if (xb_ld(&(bar)[XB_TMO])) break; if (_sp > XB_SPIN_CAP) { atomicAdd(&(bar)[XB_TMO], 1u); break; } } } } while (0)

struct XcdBarrier {
    unsigned* bar; unsigned x;
    volatile LAS unsigned* st;
};

__device__ __forceinline__ XcdBarrier xcd_barrier_post(unsigned* bar, volatile LAS unsigned* st) {
    XcdBarrier b; b.bar = bar; b.x = xb_xcc_id(); b.st = st;
    if (threadIdx.x == 0) (void)xb_add(&bar[XB_XCNT(b.x)], 1u);
    return b;
}
__device__ __forceinline__ void xcd_barrier_complete(unsigned* bar, unsigned x, unsigned& nloc, unsigned& nx) {
    const unsigned G = gridDim.x * gridDim.y * gridDim.z;
    unsigned sum, cnt, mine, sp = 0u;
    for (;;) {
        sum = 0u; cnt = 0u; mine = 0u;
#pragma unroll
        for (unsigned j = 0; j < 16; ++j) { const unsigned c = xb_ld(&bar[XB_XCNT(j)]); sum += c; cnt += (c > 0u) ? 1u : 0u; mine = (j == x) ? c : mine; }
        if (sum == G) break;
        __builtin_amdgcn_s_sleep(1);
        if ((++sp & 255u) == 0u) { if (xb_ld(&bar[XB_TMO])) break; if (sp > XB_SPIN_CAP) { atomicAdd(&bar[XB_TMO], 1u); break; } }
    }
    nloc = mine > 0u ? mine : 1u; nx = cnt > 0u ? cnt : 1u;
}

__device__ __forceinline__ void xcd_barrier(const XcdBarrier& b) {
    asm volatile("s_waitcnt vmcnt(0)" ::: "memory");
    __syncthreads();
    if (threadIdx.x == 0) {
        unsigned* bar = b.bar;
        __builtin_amdgcn_s_waitcnt(0);
        unsigned nloc = b.st[0], nx = b.st[1];
        if (nloc == 0u) { xcd_barrier_complete(bar, b.x, nloc, nx); b.st[0] = nloc; b.st[1] = nx; }
        const unsigned old = xb_add(&bar[XB_XSUB(b.x)], 1u);
        const unsigned gen = old / nloc;
        if (old + 1u == (gen + 1u) * nloc) {
            __builtin_amdgcn_fence(__ATOMIC_RELEASE, "agent");
            asm volatile("s_waitcnt vmcnt(0)" ::: "memory");
            const unsigned og = xb_add(&bar[XB_TOP], 1u);
            const unsigned tg = og / nx;
            if (og + 1u == (tg + 1u) * nx) xb_add(&bar[XB_TOPGEN], 1u);
            else XB_SPIN(xb_ld(&bar[XB_TOPGEN]) == tg, bar);
            __builtin_amdgcn_fence(__ATOMIC_ACQUIRE, "agent");
            xb_add(&bar[XB_XGEN(b.x)], 1u);
            asm volatile("s_waitcnt vmcnt(0)" ::: "memory");
        } else {
            XB_SPIN(xb_ld(&bar[XB_XGEN(b.x)]) == gen, bar);
            __builtin_amdgcn_fence(__ATOMIC_ACQUIRE, "agent");
            asm volatile("s_waitcnt vmcnt(0)" ::: "memory");
        }
    }
    __syncthreads();
}

template <int LAYER>
DI void layer_program(const Args& a, unsigned char* smem, cg::grid_group& grid, const XcdBarrier& xbar) {
    constexpr int layer = LAYER, pb = LAYER * NPH;
    unsigned char* ws = a.ws;
#define IN(k) (a.ph_lo <= (pb + (k)) && (pb + (k)) < a.ph_hi)
#define SEAM(k) do { if (IN(k) && IN((k) + 1)) { if (LAYER == 0 && (k) == 0) grid.sync(); else xcd_barrier(xbar); } } while (0)
    if (IN(0)) { phase_prep(a, layer, smem); if (PROBE_DUP & 1) { __syncthreads(); phase_prep(a, layer, smem); } }
    SEAM(0);
    if (IN(1)) { pg8::Gemm g{(const bf16_t*)(ws + WS_XN), (const bf16_t*)(ws + WS_WIN), MTOK, NP, DM}; pg8::StaticOrder S; S.init(MTOK, NP, (int)gridDim.x, (int)blockIdx.x);
                 pg8::EpiBf16<0> E{(bf16_t*)(ws + WS_PROJ), NP}; pg8::gemm_phase<pg8::EpiBf16<0>, pg8::StaticOrder, true, true>((PG8_LAS unsigned char*)smem, g, S, E);
                 if (PROBE_DUP & 2) pg8::gemm_phase<pg8::EpiBf16<0>, pg8::StaticOrder, true, true>((PG8_LAS unsigned char*)smem, g, S, E); }
    SEAM(1);
    if (IN(2)) { phase_token(a, layer, smem); phase_dsa_select<0>(a, smem); if (PROBE_DUP & 4) phase_dsa_select<PROBE_VAR>(a, smem); }
    SEAM(2);
    if (IN(3)) { phase_gla2(a); phase_attn(a, layer, smem); if (PROBE_DUP & 8) phase_attn(a, layer, smem); }
    SEAM(3);
    if (IN(4)) { phase_gla3(a, layer, smem); if (PROBE_DUP & 16) phase_gla3(a, layer, smem); }
    SEAM(4);
    if (IN(5)) { pg8::Gemm g{(const bf16_t*)(ws + WS_XN), (const bf16_t*)(ws + WS_WOUT), MTOK, DM, DM}; pg8::StaticOrder S; S.init(MTOK, DM, (int)gridDim.x, (int)blockIdx.x);
                 pg8::EpiResid E{layer == 0 ? a.in[0] : a.out, a.out, DM}; pg8::gemm_phase<pg8::EpiResid, pg8::StaticOrder, true, true>((PG8_LAS unsigned char*)smem, g, S, E); }
    SEAM(5);
    if (IN(6)) { int tid_ = threadIdx.x; asm volatile("" : "+v"(tid_)); rmsnorm_rows(a.out, a.in[17] + layer * DM, (bf16_t*)(ws + WS_XN), blockIdx.x * 8 + (tid_ >> 6), gridDim.x * 8, tid_ & 63); }
    SEAM(6);
    if (IN(7)) { pg8::Gemm g{(const bf16_t*)(ws + WS_XN), (const bf16_t*)(ws + WS_WUP), MTOK, DFF, DM}; pg8::StaticOrder S; S.init(MTOK, DFF, (int)gridDim.x, (int)blockIdx.x);
                 pg8::EpiBf16<2> E{(bf16_t*)(ws + WS_U), DFF}; pg8::gemm_phase<pg8::EpiBf16<2>, pg8::StaticOrder, true, true>((PG8_LAS unsigned char*)smem, g, S, E); }
    SEAM(7);
    if (IN(8)) { pg8::Gemm g{(const bf16_t*)(ws + WS_U), (const bf16_t*)(ws + WS_WDOWN), MTOK, DM, DFF}; pg8::StaticOrder S; S.init(MTOK, DM, (int)gridDim.x, (int)blockIdx.x);
                 pg8::EpiResid E{a.out, a.out, DM}; pg8::gemm_phase<pg8::EpiResid, pg8::StaticOrder, true, true>((PG8_LAS unsigned char*)smem, g, S, E); }
#undef IN
#undef SEAM
}

__global__ void __launch_bounds__(512, 2) fwd_kernel(Args a) {
    extern __shared__ __attribute__((aligned(16))) unsigned char smem[];
    cg::grid_group grid = cg::this_grid();
    volatile LAS unsigned* misc = (volatile LAS unsigned*)((LAS unsigned char*)smem + LDS_BYTES - 64);
    if (threadIdx.x < 16) misc[threadIdx.x] = 0u;
    __syncthreads();
    XcdBarrier xbar; xbar.bar = (unsigned*)(a.ws + WS_BAR); xbar.x = 0; xbar.st = nullptr;
    if (a.ph_hi - a.ph_lo > 1) xbar = xcd_barrier_post((unsigned*)(a.ws + WS_BAR), misc);
#define IN(k) (a.ph_lo <= (k) && (k) < a.ph_hi)
#define SEAM(k) do { if (IN(k) && IN((k) + 1)) xcd_barrier(xbar); } while (0)
    layer_program<0>(a, smem, grid, xbar);
    if (PROBE_DUP & 64) { for (int i = 0; i < 20; ++i) xcd_barrier(xbar); }
    SEAM(NPH - 1);
    layer_program<1>(a, smem, grid, xbar);
#undef IN
#undef SEAM
}

extern "C" void kernel_launch(void* const* d_in, const int* in_sizes, int n_in, void* d_out, int out_size, void* d_ws, size_t ws_size, hipStream_t stream) {
    static int grid_blocks = 0;
    if (grid_blocks == 0) {
        if (n_in != 20 || ws_size < WS_END) { fprintf(stderr, "kernel_launch: unexpected n_in %d / ws_size %zu\n", n_in, ws_size); grid_blocks = -1; return; }
        int dev = 0, cus = 0, per_cu = 0;
        hipGetDevice(&dev);
        hipDeviceGetAttribute(&cus, hipDeviceAttributeMultiprocessorCount, dev);
        hipFuncSetAttribute((const void*)fwd_kernel, hipFuncAttributeMaxDynamicSharedMemorySize, LDS_BYTES);
        hipOccupancyMaxActiveBlocksPerMultiprocessor(&per_cu, (const void*)fwd_kernel, 512, LDS_BYTES);
        if (per_cu < 1) { fprintf(stderr, "kernel_launch: occupancy query says %d blocks/CU\n", per_cu); per_cu = 1; }
        if (per_cu > 1) per_cu = 1;
        grid_blocks = cus * per_cu;
        (void)hipGetLastError();
    }
    if (grid_blocks < 0) return;
    if (hipMemsetAsync((char*)d_ws + WS_BAR, 0, WS_BAR_BYTES, stream) != hipSuccess) { fprintf(stderr, "kernel_launch: memset of the barrier words failed\n"); return; }
    Args a{};
    for (int i = 0; i < 20; ++i) a.in[i] = (const float*)d_in[i];
    a.out = (float*)d_out; a.ws = (unsigned char*)d_ws;
#if N_LAUNCH_MODE == 1
    a.ph_lo = 0; a.ph_hi = 2 * NPH;
    void* args[] = {&a};
    hipError_t e = hipLaunchCooperativeKernel((const void*)fwd_kernel, dim3(grid_blocks), dim3(512), args, LDS_BYTES, stream);
    if (e != hipSuccess) fprintf(stderr, "cooperative launch failed: %s (grid %d)\n", hipGetErrorString(e), grid_blocks);
#else
    for (int ph = 0; ph < 2 * NPH; ++ph) {
        a.ph_lo = ph; a.ph_hi = ph + 1;
        hipLaunchKernelGGL(fwd_kernel, dim3(grid_blocks), dim3(512), LDS_BYTES, stream, a);
    }
#endif
}
```
